# Optimizing an MI355X kernel written in HIP

```python
import math
import jax
import jax.numpy as jnp
from jax import lax
import numpy as np

D_MODEL = 2048
BATCH = 8
SEQ = 4096
DEPTH = 2

GRID_W = 64
CTX_LEN = 256
N_MIXERS = 2
N_ATTN_LAYERS = (DEPTH + N_MIXERS - 1) // N_MIXERS
N_LRU_LAYERS = DEPTH // N_MIXERS
N_SUBLAYERS = 3
DA_HEAD_DIM = 64
DA_HEADS = D_MODEL // (2 * DA_HEAD_DIM)
DA_V_DIM = 2 * DA_HEAD_DIM
Q_BLOCK = 128
ROPE_BASE = 10000.0
AXIS_ROT_DIM = DA_HEAD_DIM // 2
D_RNN = 2560
LRU_BLOCKS = 10
LRU_BLOCK_W = D_RNN // LRU_BLOCKS
CONV_W = 4
CONV_PAD_LEFT = 2
CONV_PAD_RIGHT = CONV_W - 1 - CONV_PAD_LEFT
LRU_C = 8.0
A_MIN = 0.9
A_MAX = 0.999
D_FF = 5632
FFN_RES_WEIGHT = 0.5
ALPHA = (2.0 * DEPTH) ** 0.25
BETA = (8.0 * DEPTH) ** -0.25
LN_EPS = 1e-6

kernel_name = "hybrid_diffattn_rglru_macaron_dit"


def layer_norm(x, g, b):
    xf = x.astype(jnp.float32)
    mu = jnp.mean(xf, axis=-1, keepdims=True)
    var = jnp.mean(jnp.square(xf - mu), axis=-1, keepdims=True)
    y = (xf - mu) * lax.rsqrt(var + LN_EPS)
    return (y * g.astype(jnp.float32) + b.astype(jnp.float32)).astype(x.dtype)


def rms_norm(x, g):
    xf = x.astype(jnp.float32)
    y = xf * lax.rsqrt(jnp.mean(jnp.square(xf), axis=-1, keepdims=True) + LN_EPS)
    return (y * g.astype(jnp.float32)).astype(x.dtype)


def modulate(x, shift, scale):
    return x * (1 + scale) + shift


def split_mod(mod):
    return mod[..., 0, :, :], mod[..., 1, :, :], mod[..., 2, :, :]


def swiglu(u, w_gate, w_up, w_down):
    return (jax.nn.silu(u @ w_gate) * (u @ w_up)) @ w_down


def ffn_sublayer(x, mod, w_gate, w_up, w_down, g, b):
    shift, scale, gate = split_mod(mod)
    h = swiglu(modulate(x, shift, scale), w_gate, w_up, w_down)
    return layer_norm(ALPHA * x + FFN_RES_WEIGHT * gate * h, g, b)


def axial_rope_tables(n_tokens):
    rows = n_tokens // GRID_W
    row = jnp.repeat(jnp.arange(rows, dtype=jnp.float32), GRID_W)
    col = jnp.tile(jnp.arange(GRID_W, dtype=jnp.float32), rows)
    inv_freq = ROPE_BASE ** (-jnp.arange(0, AXIS_ROT_DIM, 2, dtype=jnp.float32) / AXIS_ROT_DIM)
    ang_r = row[:, None] * inv_freq[None, :]
    ang_c = col[:, None] * inv_freq[None, :]
    return jnp.cos(ang_r), jnp.sin(ang_r), jnp.cos(ang_c), jnp.sin(ang_c)


def _rope_1d(x, cos, sin):
    cos = cos[:, None, None, :].astype(x.dtype)
    sin = sin[:, None, None, :].astype(x.dtype)
    x1, x2 = jnp.split(x, 2, axis=-1)
    return jnp.concatenate([x1 * cos - x2 * sin, x1 * sin + x2 * cos], axis=-1)


def apply_axial_rope(x, tables):
    cos_r, sin_r, cos_c, sin_c = tables
    x_row, x_col = jnp.split(x, 2, axis=-1)
    return jnp.concatenate([_rope_1d(x_row, cos_r, sin_r), _rope_1d(x_col, cos_c, sin_c)], axis=-1)


def diff_attn_core(q, k, v, lam):
    s = jnp.einsum('bqhed,bkhed->bheqk', q * (DA_HEAD_DIM ** -0.5), k,
                   preferred_element_type=jnp.float32)
    p = jax.nn.softmax(s, axis=-1)
    a = p[:, :, 0] - lam * p[:, :, 1]
    return jnp.einsum('bhqk,bkhv->bqhv', a.astype(v.dtype), v)


def diff_attention(u, uc, w_qkv, w_o, lq1, lk1, lq2, lk2, subln_g, lambda_init, need_ctx):
    B, S, _ = u.shape
    f32 = jnp.float32
    lam = (jnp.exp(jnp.sum(lq1.astype(f32) * lk1.astype(f32)))
           - jnp.exp(jnp.sum(lq2.astype(f32) * lk2.astype(f32))) + lambda_init)

    def proj(t):
        n = t.shape[1]
        q, k, v = jnp.split(t @ w_qkv, 3, axis=-1)
        return (q.reshape(B, n, DA_HEADS, 2, DA_HEAD_DIM),
                k.reshape(B, n, DA_HEADS, 2, DA_HEAD_DIM),
                v.reshape(B, n, DA_HEADS, DA_V_DIM))

    def finish(o):
        o = rms_norm(o, subln_g) * (1.0 - lambda_init)
        return o.reshape(o.shape[0], o.shape[1], D_MODEL) @ w_o

    tables = axial_rope_tables(S)
    q, k, v = proj(u)
    q = apply_axial_rope(q, tables)
    k = apply_axial_rope(k, tables)
    qc, kc, vc = proj(uc)
    k_all = jnp.concatenate([kc, k], axis=1)
    v_all = jnp.concatenate([vc, v], axis=1)
    n_blk = S // Q_BLOCK
    q_blocks = jnp.moveaxis(q.reshape(B, n_blk, Q_BLOCK, DA_HEADS, 2, DA_HEAD_DIM), 1, 0)
    o = lax.map(lambda qb: diff_attn_core(qb, k_all, v_all, lam), q_blocks)
    o = jnp.moveaxis(o, 0, 1).reshape(B, S, DA_HEADS, DA_V_DIM)
    out = finish(o)
    out_c = finish(diff_attn_core(qc, kc, vc, lam)) if need_ctx else None
    return out, out_c


def depthwise_conv_centred(x, w, b):
    n = x.shape[1]
    xp = jnp.pad(x, ((0, 0), (CONV_PAD_LEFT, CONV_PAD_RIGHT), (0, 0)))
    y = xp[:, 0:n] * w[0]
    for j in range(1, CONV_W):
        y = y + xp[:, j:j + n] * w[j]
    return y + b


def block_diag_linear(x, w, b):
    xb = x.reshape(x.shape[0], x.shape[1], LRU_BLOCKS, LRU_BLOCK_W)
    y = jnp.einsum('bnhi,hij->bnhj', xb, w)
    return y.reshape(x.shape) + b


def rglru_coeffs(xr, w_a, b_a, w_i, b_i, a_param):
    f32 = jnp.float32
    r = jax.nn.sigmoid(block_diag_linear(xr, w_a, b_a)).astype(f32)
    i = jax.nn.sigmoid(block_diag_linear(xr, w_i, b_i)).astype(f32)
    log_a = -LRU_C * r * jax.nn.softplus(-a_param.astype(f32))
    a = jnp.exp(log_a)
    mult = jnp.sqrt(-jnp.expm1(2.0 * log_a))
    return a, mult * i * xr.astype(f32)


def _combine(left, right):
    a1, b1 = left
    a2, b2 = right
    return a1 * a2, a2 * b1 + b2


def linear_scan(a, b, h0, reverse):
    a_cum, b_cum = lax.associative_scan(_combine, (a, b), reverse=reverse, axis=1)
    if h0 is None:
        return b_cum
    return b_cum + a_cum * h0[:, None, :]


def rglru_mixer(u, uc, w_in, conv_w, conv_b, w_a, b_a, w_i, b_i, a_param, w_out, need_ctx):
    def branches(t):
        g, xr = jnp.split(t @ w_in, 2, axis=-1)
        return jax.nn.gelu(g), depthwise_conv_centred(xr, conv_w, conv_b)

    g, xr = branches(u)
    gc, xrc = branches(uc)
    h_lat = []
    h_ctx = []
    for d, rev in enumerate((False, True)):
        ac, bc = rglru_coeffs(xrc, w_a[d], b_a[d], w_i[d], b_i[d], a_param[d])
        hc = linear_scan(ac, bc, None, rev)
        h0 = hc[:, 0] if rev else hc[:, -1]
        a, b = rglru_coeffs(xr, w_a[d], b_a[d], w_i[d], b_i[d], a_param[d])
        h_lat.append(linear_scan(a, b, h0, rev))
        h_ctx.append(hc)
    out = ((h_lat[0] + h_lat[1]).astype(u.dtype) * g) @ w_out
    out_c = (((h_ctx[0] + h_ctx[1]).astype(uc.dtype) * gc) @ w_out) if need_ctx else None
    return out, out_c


def _normal(key, shape, scale):
    return jax.random.normal(key, shape, jnp.float32) * scale


def setup_inputs(seed: int = 0) -> dict:
    key = jax.random.key(seed)
    ks = jax.random.split(key, 28)
    D = D_MODEL
    a0 = jax.random.uniform(ks[25], (N_LRU_LAYERS, 2, D_RNN), jnp.float32, A_MIN, A_MAX)
    return {
        "x": _normal(ks[0], (BATCH, SEQ, D), 1.0),
        "c": _normal(ks[1], (BATCH, D), 1.0),
        "ctx": _normal(ks[2], (BATCH, CTX_LEN, D), 1.0),
        "c_ctx": _normal(ks[3], (D,), 1.0),
        "w_ada": _normal(ks[4], (DEPTH, D, N_SUBLAYERS * 3 * D), 0.5 * D ** -0.5),
        "b_ada": _normal(ks[5], (DEPTH, N_SUBLAYERS * 3 * D), 0.02),
        "ln_g": 1.0 + _normal(ks[6], (DEPTH, N_SUBLAYERS, D), 0.02),
        "ln_b": _normal(ks[7], (DEPTH, N_SUBLAYERS, D), 0.02),
        "ffn_w_gate": _normal(ks[8], (DEPTH, 2, D, D_FF), D ** -0.5),
        "ffn_w_up": _normal(ks[9], (DEPTH, 2, D, D_FF), D ** -0.5),
        "ffn_w_down": _normal(ks[10], (DEPTH, 2, D_FF, D), BETA * D_FF ** -0.5),
        "attn_w_qkv": _normal(ks[11], (N_ATTN_LAYERS, D, 3 * D), D ** -0.5),
        "attn_w_o": _normal(ks[12], (N_ATTN_LAYERS, D, D), BETA * D ** -0.5),
        "attn_lambda_q1": _normal(ks[13], (N_ATTN_LAYERS, DA_HEAD_DIM), 0.1),
        "attn_lambda_k1": _normal(ks[14], (N_ATTN_LAYERS, DA_HEAD_DIM), 0.1),
        "attn_lambda_q2": _normal(ks[15], (N_ATTN_LAYERS, DA_HEAD_DIM), 0.1),
        "attn_lambda_k2": _normal(ks[16], (N_ATTN_LAYERS, DA_HEAD_DIM), 0.1),
        "attn_subln_g": 1.0 + _normal(ks[17], (N_ATTN_LAYERS, DA_V_DIM), 0.02),
        "lru_w_in": _normal(ks[18], (N_LRU_LAYERS, D, 2 * D_RNN), D ** -0.5),
        "lru_conv_w": _normal(ks[19], (N_LRU_LAYERS, CONV_W, D_RNN), CONV_W ** -0.5),
        "lru_conv_b": _normal(ks[20], (N_LRU_LAYERS, D_RNN), 0.02),
        "lru_w_a": _normal(ks[21], (N_LRU_LAYERS, 2, LRU_BLOCKS, LRU_BLOCK_W, LRU_BLOCK_W), LRU_BLOCK_W ** -0.5),
        "lru_b_a": _normal(ks[22], (N_LRU_LAYERS, 2, D_RNN), 0.02),
        "lru_w_i": _normal(ks[23], (N_LRU_LAYERS, 2, LRU_BLOCKS, LRU_BLOCK_W, LRU_BLOCK_W), LRU_BLOCK_W ** -0.5),
        "lru_b_i": _normal(ks[24], (N_LRU_LAYERS, 2, D_RNN), 0.02),
        "lru_a_param": jnp.log(a0) - jnp.log1p(-a0),
        "lru_w_out": _normal(ks[26], (N_LRU_LAYERS, D_RNN, D), BETA * D_RNN ** -0.5),
    }


def reference(x, c, ctx, c_ctx, w_ada, b_ada, ln_g, ln_b, ffn_w_gate, ffn_w_up, ffn_w_down,
              attn_w_qkv, attn_w_o, attn_lambda_q1, attn_lambda_k1, attn_lambda_q2, attn_lambda_k2,
              attn_subln_g, lru_w_in, lru_conv_w, lru_conv_b, lru_w_a, lru_b_a, lru_w_i, lru_b_i,
              lru_a_param, lru_w_out):
    B, S, D = x.shape
    xc = ctx
    for i in range(DEPTH):
        need_ctx = i < DEPTH - 1
        m = (jax.nn.silu(c) @ w_ada[i] + b_ada[i]).reshape(B, N_SUBLAYERS, 3, 1, D)
        mc = (jax.nn.silu(c_ctx) @ w_ada[i] + b_ada[i]).reshape(N_SUBLAYERS, 3, 1, D)

        x = ffn_sublayer(x, m[:, 0], ffn_w_gate[i, 0], ffn_w_up[i, 0], ffn_w_down[i, 0], ln_g[i, 0], ln_b[i, 0])
        xc = ffn_sublayer(xc, mc[0], ffn_w_gate[i, 0], ffn_w_up[i, 0], ffn_w_down[i, 0], ln_g[i, 0], ln_b[i, 0])

        sh, sc, gt = split_mod(m[:, 1])
        shc, scc, gtc = split_mod(mc[1])
        u = modulate(x, sh, sc)
        uc = modulate(xc, shc, scc)
        j = i // N_MIXERS
        if i % N_MIXERS == 0:
            lambda_init = 0.8 - 0.6 * math.exp(-0.3 * i)
            o, oc = diff_attention(u, uc, attn_w_qkv[j], attn_w_o[j], attn_lambda_q1[j], attn_lambda_k1[j],
                                   attn_lambda_q2[j], attn_lambda_k2[j], attn_subln_g[j], lambda_init, need_ctx)
        else:
            o, oc = rglru_mixer(u, uc, lru_w_in[j], lru_conv_w[j], lru_conv_b[j], lru_w_a[j], lru_b_a[j],
                                lru_w_i[j], lru_b_i[j], lru_a_param[j], lru_w_out[j], need_ctx)
        x = layer_norm(ALPHA * x + gt * o, ln_g[i, 1], ln_b[i, 1])
        if need_ctx:
            xc = layer_norm(ALPHA * xc + gtc * oc, ln_g[i, 1], ln_b[i, 1])

        x = ffn_sublayer(x, m[:, 2], ffn_w_gate[i, 1], ffn_w_up[i, 1], ffn_w_down[i, 1], ln_g[i, 2], ln_b[i, 2])
        if need_ctx:
            xc = ffn_sublayer(xc, mc[2], ffn_w_gate[i, 1], ffn_w_up[i, 1], ffn_w_down[i, 1], ln_g[i, 2], ln_b[i, 2])
    return x
```

```cpp
#include <hip/hip_runtime.h>
#include <cstdio>
#include <cstdint>

#define LAS __attribute__((address_space(3)))
#define GAS __attribute__((address_space(1)))
typedef unsigned short bf16_t;
typedef short bf16x8 __attribute__((ext_vector_type(8)));
typedef float f32x4 __attribute__((ext_vector_type(4)));
typedef float f32x2 __attribute__((ext_vector_type(2)));
typedef float f32x16 __attribute__((ext_vector_type(16)));
typedef unsigned u32x4 __attribute__((ext_vector_type(4)));
typedef unsigned u32x2 __attribute__((ext_vector_type(2)));
typedef GAS unsigned gu32;

constexpr int D = 2048, NB = 8, SEQ = 4096, CTXL = 256;
constexpr int TL = NB * SEQ;
constexpr int TC = NB * CTXL;
constexpr int T = TL + TC;
constexpr int HKT = 5632 / 64;
constexpr int WP2 = 2048 + 64, WP5 = 5632 + 128, WPR = 2560 + 64;
constexpr int FF = 5632, DR = 2560, NMOD = 9 * D;
constexpr float ALPHA = 1.4142135623730951f;
constexpr float LN_EPS = 1e-6f;
constexpr float LOG2E = 1.4426950408889634f;
constexpr float QSCALE = 0.125f * LOG2E;
constexpr int QROWS = 34 * 256;

constexpr size_t MiB = 1u << 20;
constexpr size_t WS_CTL = 0, CTL_ZERO_BYTES = 1 * MiB;
constexpr size_t WS_MOD = 1 * MiB;
constexpr size_t WS_TAB = 3 * MiB;
constexpr size_t WS_LAM = 3 * MiB + 16384;
constexpr size_t WS_C8 = 3 * MiB + 32768;
constexpr size_t WS_STATS = 3 * MiB + 131072;
constexpr size_t WS_WGU = 4 * MiB;
constexpr size_t SZ_WGU = (size_t)11264 * WP2 * 2, SZ_WD = (size_t)2048 * WP5 * 2;
constexpr size_t WS_WD = 186 * MiB;
constexpr size_t WS_WQK = 276 * MiB, WS_WV = 293 * MiB, WS_WO = 302 * MiB;
constexpr size_t WS_WIN = 311 * MiB, WS_WAI = 332 * MiB, WS_WOUT = 337 * MiB;
static_assert(WS_WGU + 4 * SZ_WGU <= WS_WD && WS_WD + 4 * SZ_WD <= WS_WQK && WS_WQK + (size_t)4096 * WP2 * 2 <= WS_WV && WS_WV + (size_t)2048 * WP2 * 2 <= WS_WO && WS_WO + (size_t)2048 * WP2 * 2 <= WS_WIN
              && WS_WIN + (size_t)5120 * WP2 * 2 <= WS_WAI && WS_WAI + (size_t)10240 * 256 * 2 <= WS_WOUT && WS_WOUT + (size_t)2048 * WPR * 2 <= 348 * MiB, "weight map");
constexpr size_t WS_X = 348 * MiB;
constexpr size_t WS_U = 620 * MiB;
constexpr size_t WS_H = 756 * MiB;
constexpr size_t WS_Q = 756 * MiB, WS_K = 892 * MiB, WS_VT = 1028 * MiB, WS_O = 620 * MiB;
constexpr size_t WS_GG = 620 * MiB, WS_XR = 790 * MiB, WS_XC = 960 * MiB, WS_ULRU = 960 * MiB, WS_AB = 790 * MiB;
constexpr size_t AB_ARR = (size_t)QROWS * DR * 2;
constexpr size_t WS_PH = 1130 * MiB;
constexpr size_t WS_CARRY = 1138 * MiB;
constexpr size_t WS_PART = 1146 * MiB;
constexpr size_t WS_END = 1210 * MiB;
static_assert(WS_H + (size_t)T * FF * 2 <= WS_PART && WS_XC + (size_t)T * DR * 2 <= WS_PH, "activation map");
static_assert(WS_AB + 4 * AB_ARR <= WS_XC, "AB fits in XR's region");

constexpr int CW_BAR = 4096;
constexpr int LDS_BYTES = 147456;
constexpr int MISC_OFF = 131072 + 320;

typedef __bf16 bf16x2_t __attribute__((ext_vector_type(2)));
__device__ __forceinline__ unsigned cvt_pk_bf16(float lo, float hi) { f32x2 v = {lo, hi}; bf16x2_t b = __builtin_convertvector(v, bf16x2_t); return __builtin_bit_cast(unsigned, b); }
__device__ __forceinline__ unsigned f2bf(float f) { unsigned u = __builtin_bit_cast(unsigned, f); return (u + 0x7fffu + ((u >> 16) & 1u)) >> 16; }
__device__ __forceinline__ unsigned pk2(float lo, float hi) { return f2bf(lo) | (f2bf(hi) << 16); }
__device__ __forceinline__ float bf_lo(unsigned w) { return __uint_as_float(w << 16); }
__device__ __forceinline__ float bf_hi(unsigned w) { return __uint_as_float(w & 0xffff0000u); }
typedef _Float16 h2_t __attribute__((ext_vector_type(2)));
__device__ __forceinline__ unsigned pk_f16(float a, float b) { h2_t v = {(_Float16)a, (_Float16)b}; return __builtin_bit_cast(unsigned, v); }
__device__ __forceinline__ float h_lo(unsigned w) { h2_t v = __builtin_bit_cast(h2_t, w); return (float)v.x; }
__device__ __forceinline__ float h_hi(unsigned w) { h2_t v = __builtin_bit_cast(h2_t, w); return (float)v.y; }
__device__ __forceinline__ float fast_sigmoid(float x) { return __builtin_amdgcn_rcpf(1.0f + __builtin_amdgcn_exp2f(-LOG2E * x)); }
__device__ __forceinline__ float wave_sum(float v) {
#pragma unroll
    for (int o = 1; o < 64; o <<= 1) v += __shfl_xor(v, o);
    return v;
}
__device__ __forceinline__ float swap32(float v) { return __shfl_xor(v, 32); }

#define XB_TMO      128
#define XB_XCNT(j)  (256  + 64 * (j))
#define XB_XSUB(j)  (1280 + 64 * (j))
#define XB_XGEN(j)  (2304 + 64 * (j))
#define XB_TOP      3328
#define XB_TOPGEN   3392
#define XCD_BAR_WORDS 3456
#define XB_SPIN_CAP (1u << 22)
__device__ __forceinline__ unsigned xb_ld(unsigned* p)              { return __hip_atomic_load(p, __ATOMIC_RELAXED, __HIP_MEMORY_SCOPE_AGENT); }
__device__ __forceinline__ unsigned xb_add(unsigned* p, unsigned v) { return __hip_atomic_fetch_add(p, v, __ATOMIC_RELAXED, __HIP_MEMORY_SCOPE_AGENT); }
__device__ __forceinline__ unsigned xb_xcc_id() { return (unsigned)__builtin_amdgcn_s_getreg((3 << 11) | 20) & 0xFu; }
#define XB_SPIN(cond, bar) do { unsigned _sp = 0; while (cond) { __builtin_amdgcn_s_sleep(1); \
    if ((++_sp & 255u) == 0u) { if (xb_ld(&(bar)[XB_TMO])) break; if (_sp > XB_SPIN_CAP) { atomicAdd(&(bar)[XB_TMO], 1u); break; } } } } while (0)
struct XcdBarrier { unsigned* bar; unsigned x; volatile LAS unsigned* st; };
__device__ __forceinline__ XcdBarrier xcd_barrier_post(unsigned* bar, volatile LAS unsigned* st) {
    XcdBarrier b; b.bar = bar; b.x = xb_xcc_id(); b.st = st;
    if (threadIdx.x == 0) (void)xb_add(&bar[XB_XCNT(b.x)], 1u);
    return b;
}
__device__ __forceinline__ void xcd_barrier_complete(unsigned* bar, unsigned x, unsigned& nloc, unsigned& nx) {
    const unsigned G = gridDim.x * gridDim.y * gridDim.z;
    unsigned sum, cnt, mine, sp = 0u;
    for (;;) {
        sum = 0u; cnt = 0u; mine = 0u;
#pragma unroll
        for (unsigned j = 0; j < 16; ++j) { const unsigned c = xb_ld(&bar[XB_XCNT(j)]); sum += c; cnt += (c > 0u) ? 1u : 0u; mine = (j == x) ? c : mine; }
        if (sum == G) break;
        __builtin_amdgcn_s_sleep(1);
        if ((++sp & 255u) == 0u) { if (xb_ld(&bar[XB_TMO])) break; if (sp > XB_SPIN_CAP) { atomicAdd(&bar[XB_TMO], 1u); break; } }
    }
    nloc = mine > 0u ? mine : 1u; nx = cnt > 0u ? cnt : 1u;
}
__device__ __forceinline__ void xcd_barrier(const XcdBarrier& b) {
    asm volatile("s_waitcnt vmcnt(0)" ::: "memory");
    __syncthreads();
    if (threadIdx.x == 0) {
        unsigned* bar = b.bar;
        __builtin_amdgcn_s_waitcnt(0);
        unsigned nloc = b.st[0], nx = b.st[1];
        if (nloc == 0u) { xcd_barrier_complete(bar, b.x, nloc, nx); b.st[0] = nloc; b.st[1] = nx; }
        const unsigned old = xb_add(&bar[XB_XSUB(b.x)], 1u);
        const unsigned gen = old / nloc;
        if (old + 1u == (gen + 1u) * nloc) {
            __builtin_amdgcn_fence(__ATOMIC_RELEASE, "agent");
            asm volatile("s_waitcnt vmcnt(0)" ::: "memory");
            const unsigned og = xb_add(&bar[XB_TOP], 1u);
            const unsigned tg = og / nx;
            if (og + 1u == (tg + 1u) * nx) xb_add(&bar[XB_TOPGEN], 1u);
            else XB_SPIN(xb_ld(&bar[XB_TOPGEN]) == tg, bar);
            __builtin_amdgcn_fence(__ATOMIC_ACQUIRE, "agent");
            xb_add(&bar[XB_XGEN(b.x)], 1u);
            asm volatile("s_waitcnt vmcnt(0)" ::: "memory");
        } else {
            XB_SPIN(xb_ld(&bar[XB_XGEN(b.x)]) == gen, bar);
            __builtin_amdgcn_fence(__ATOMIC_ACQUIRE, "agent");
            asm volatile("s_waitcnt vmcnt(0)" ::: "memory");
        }
    }
    __syncthreads();
}

namespace pg8 {
constexpr int BM = 256, BK = 64, HALF = 128, HTB = HALF * BK * 2, STAGE_BYTES = 8 * HTB, NXCD = 8, WGM = 4;
__host__ __device__ __forceinline__ int lds_byte(int r, int c) { const int st = (r >> 4) * 2 + (c >> 5), rr = r & 15, cc = c & 31, ob = rr * 64 + cc * 2; return st * 1024 + (ob ^ (((ob >> 9) & 1) << 5)); }
__host__ __device__ __forceinline__ void stage_rc(int b, int& R, int& C) { const int st = b / 1024, sb = b % 1024, swz = sb ^ (((sb >> 9) & 1) << 5); R = (st >> 1) * 16 + swz / 64; C = (st & 1) * 32 + (swz % 64) / 2; }
__host__ __device__ __forceinline__ int perm32(int rho) { const int n = rho >> 4, i = rho & 15; return 8 * (i >> 2) + 4 * n + (i & 3); }

struct Unit { int pm, pn; size_t aoff, boff; int kt, part; };
struct Gemm { const bf16_t* A; const bf16_t* Bt; int lda, ldb, K; size_t kstepA = 128, kstepB = 128; };

__device__ __forceinline__ bool order_next(int nM, int nN, int G, int c, int i, int& pm, int& pn) {
    const int nwg = nM * nN; const long L = (long)i * G + c; if (L >= nwg) return false;
    int wgid = (int)L; { const int q = nwg / NXCD, r = nwg % NXCD, xcd = wgid % NXCD, off = wgid / NXCD; wgid = (xcd < r ? xcd * (q + 1) : r * (q + 1) + (xcd - r) * q) + off; }
    const int nig = WGM * nN, gid = wgid / nig, fm = gid * WGM, gsz = (nM - fm) < WGM ? (nM - fm) : WGM;
    pm = fm + ((wgid % nig) % gsz); pn = (wgid % nig) / gsz; return true;
}
struct StdOrder {
    int nM, nN, G, c, kt; size_t astep, bstep;
    __device__ __forceinline__ void init(int M, int N, int lda, int ldb, int K, int G_, int c_) { nM = M / BM; nN = N / BM; G = G_; c = c_; kt = K / BK; astep = (size_t)BM * lda * 2; bstep = (size_t)BM * ldb * 2; }
    __device__ __forceinline__ bool next(int i, Unit& u) const { if (!order_next(nM, nN, G, c, i, u.pm, u.pn)) return false; u.aoff = (size_t)u.pm * astep; u.boff = (size_t)u.pn * bstep; u.kt = kt; u.part = -1; return true; }
};
struct SplitOrder {
    int G, c, K; size_t astep, bstep, kqA, kqB;
    __device__ __forceinline__ void init(int lda, int ldb, int K_, int G_, int c_) { G = G_; c = c_; K = K_; astep = (size_t)BM * lda * 2; bstep = (size_t)BM * ldb * 2; kqA = (size_t)(K_ / 4) * 2; kqB = kqA; }
    __device__ __forceinline__ bool next(int i, Unit& u) const {
        if (order_next(128, 8, G, c, i, u.pm, u.pn)) { u.aoff = (size_t)u.pm * astep; u.boff = (size_t)u.pn * bstep; u.kt = K / BK; u.part = -1; return true; }
        const long s = (long)i * G + c - 1024; if (s < 0 || s >= 256) return false;
        const int cu = (int)s >> 2, ks = (int)s & 3, kq = K / 4;
        u.pm = 128 + (cu >> 3); u.pn = cu & 7; u.aoff = (size_t)u.pm * astep + (size_t)ks * kqA; u.boff = (size_t)u.pn * bstep + (size_t)ks * kqB; u.kt = kq / BK; u.part = ks; return true;
    }
};
struct GateOrder {
    int G, c, q;
    __device__ __forceinline__ bool next(int i, Unit& u) const {
        if (!order_next(34, 40, G, c, i, u.pm, u.pn)) return false;
        const int gp = u.pm < 32 ? 32 * q + u.pm : 128 + 2 * q + (u.pm - 32);
        const int blk = (u.pn % 20) >> 1;
        u.aoff = ((size_t)gp * BM * DR + (size_t)blk * 256) * 2; u.boff = (size_t)u.pn * BM * 256 * 2; u.kt = 4; u.part = -1; return true;
    }
};

template <class Epi, class Sched, bool ALIGN_EPI>
__device__ __forceinline__ void gemm_phase(LAS unsigned char* lds, const Gemm g, const Sched& S, const Epi& E) {
    int tid = threadIdx.x; asm volatile("" : "+v"(tid));
    const int wid = __builtin_amdgcn_readfirstlane(tid >> 6), lane = tid & 63, wr = wid >> 2, wc = wid & 3, fr = lane & 15, fq = lane >> 4;
    unsigned voffA[2], voffB[2];
#pragma unroll
    for (int i = 0; i < 2; ++i) { int R, C; stage_rc(tid * 16 + i * 8192, R, C); const int Rb = Epi::PERM ? ((R & ~31) + perm32(R & 31)) : R;
        voffA[i] = (unsigned)(R * g.lda + C) * 2u; voffB[i] = (unsigned)(Rb * g.ldb + C) * 2u; }
    const size_t kstep = g.kstepB, kstepA = g.kstepA;
    const size_t hstepA = (size_t)HALF * g.lda * 2, hstepB = (size_t)HALF * g.ldb * 2;
    const unsigned ldsw = (unsigned)wid * 1024u;
    const int aoff = lds_byte(wr * 64 + fr, fq * 8), boff = lds_byte(wc * 32 + fr, fq * 8);
#define PG8_SA(b, h) (((b) * 2 + (h)) * HTB)
#define PG8_SB(b, h) ((4 + (b) * 2 + (h)) * HTB)
#define PG8_STAGE(bufoff, gbase, voff) do { _Pragma("unroll") for (int _i = 0; _i < 2; ++_i) \
        __builtin_amdgcn_global_load_lds((const unsigned*)((const char*)(gbase) + (voff)[_i]), (LAS unsigned*)(lds + (bufoff) + ldsw + _i * 8192), 16, 0, 0); } while (0)
#define PG8_LDA(dst, b, h) do { _Pragma("unroll") for (int m = 0; m < 4; ++m) _Pragma("unroll") for (int k = 0; k < 2; ++k) dst[m][k] = *(const LAS bf16x8*)(lds + PG8_SA(b, h) + aoff + m * 2048 + k * 1024); } while (0)
#define PG8_LDB(dst, b, h) do { _Pragma("unroll") for (int n = 0; n < 2; ++n) _Pragma("unroll") for (int k = 0; k < 2; ++k) dst[n][k] = *(const LAS bf16x8*)(lds + PG8_SB(b, h) + boff + n * 2048 + k * 1024); } while (0)
#define PG8_MMA(ai, bj, At, Bt) do { __builtin_amdgcn_s_setprio(1); _Pragma("unroll") for (int m = 0; m < 4; ++m) _Pragma("unroll") for (int n = 0; n < 2; ++n) _Pragma("unroll") for (int k = 0; k < 2; ++k) \
        acc[ai][bj][m][n] = __builtin_amdgcn_mfma_f32_16x16x32_bf16(Bt[n][k], At[m][k], acc[ai][bj][m][n], 0, 0, 0); __builtin_amdgcn_s_setprio(0); } while (0)
#define PG8_WAIT_V(n) asm volatile("s_waitcnt vmcnt(" #n ")" ::: "memory")
#define PG8_WAIT_L(n) asm volatile("s_waitcnt lgkmcnt(" #n ")" ::: "memory")
#define PG8_BAR __builtin_amdgcn_s_barrier()
#define PG8_SCHED __builtin_amdgcn_sched_barrier(0)
    Unit cur, nxt; int ui = 0;
    if (!S.next(0, cur)) return;
    f32x4 acc[2][2][4][2];
#pragma unroll
    for (int a = 0; a < 2; ++a)
#pragma unroll
        for (int b = 0; b < 2; ++b)
#pragma unroll
            for (int m = 0; m < 4; ++m)
#pragma unroll
                for (int n = 0; n < 2; ++n) acc[a][b][m][n] = (f32x4){0.f, 0.f, 0.f, 0.f};
    bf16x8 At[4][2], B0[2][2], B1[2][2];
    const char* cA = (const char*)g.A + cur.aoff; const char* cB = (const char*)g.Bt + cur.boff;
    PG8_STAGE(PG8_SB(0, 0), cB, voffB); PG8_STAGE(PG8_SB(0, 1), cB + hstepB, voffB); PG8_STAGE(PG8_SA(0, 0), cA, voffA); PG8_STAGE(PG8_SA(0, 1), cA + hstepA, voffA);
    if (wr == 1) PG8_BAR;
    PG8_WAIT_V(2); PG8_BAR;
    PG8_STAGE(PG8_SB(1, 0), cB + kstep, voffB); PG8_STAGE(PG8_SA(1, 0), cA + kstepA, voffA); PG8_STAGE(PG8_SB(1, 1), cB + hstepB + kstep, voffB);
    PG8_WAIT_V(6); PG8_BAR;
    for (;;) {
        const bool has_next = S.next(ui + 1, nxt);
        const char* nA = has_next ? (const char*)g.A + nxt.aoff : cA; const char* nB = has_next ? (const char*)g.Bt + nxt.boff : cB;
        const int nt = cur.kt;
#pragma unroll 1
        for (int t = 0; t < nt; t += 2) {
            const bool last = (t == nt - 2);
            const char* a1 = cA + (size_t)(t + 1) * kstepA;
            const char* a2 = last ? nA : cA + (size_t)(t + 2) * kstepA; const char* b2 = last ? nB : cB + (size_t)(t + 2) * kstep;
            const char* a3 = a2 + kstepA; const char* b3 = b2 + kstep;
            PG8_LDB(B0, 0, 0); PG8_LDB(B1, 0, 1); PG8_SCHED; PG8_LDA(At, 0, 0); PG8_STAGE(PG8_SA(1, 1), a1 + hstepA, voffA);
            PG8_WAIT_V(8); PG8_WAIT_L(0); PG8_BAR; PG8_MMA(0, 0, At, B0); PG8_MMA(0, 1, At, B1); PG8_BAR; PG8_SCHED;
            PG8_LDA(At, 0, 1); PG8_STAGE(PG8_SB(0, 0), b2, voffB); PG8_STAGE(PG8_SB(0, 1), b2 + hstepB, voffB); PG8_STAGE(PG8_SA(0, 0), a2, voffA);
            PG8_WAIT_V(8); PG8_WAIT_L(0); PG8_BAR; PG8_MMA(1, 0, At, B0); PG8_MMA(1, 1, At, B1); PG8_BAR; PG8_SCHED;
            PG8_LDB(B0, 1, 0); PG8_LDB(B1, 1, 1); PG8_SCHED; PG8_LDA(At, 1, 0); PG8_STAGE(PG8_SA(0, 1), a2 + hstepA, voffA);
            PG8_WAIT_V(8); PG8_WAIT_L(0); PG8_BAR; PG8_MMA(0, 0, At, B0); PG8_MMA(0, 1, At, B1); PG8_BAR; PG8_SCHED;
            PG8_LDA(At, 1, 1); PG8_STAGE(PG8_SB(1, 0), b3, voffB); PG8_STAGE(PG8_SB(1, 1), b3 + hstepB, voffB); PG8_STAGE(PG8_SA(1, 0), a3, voffA);
            PG8_WAIT_V(8); PG8_WAIT_L(0); PG8_BAR; PG8_MMA(1, 0, At, B0); PG8_MMA(1, 1, At, B1); PG8_BAR; PG8_SCHED;
        }
        if constexpr (ALIGN_EPI) { if (wr == 0) PG8_BAR; }
        E(acc, cur, wr, wc, fr, fq);
        if (!has_next) break;
#pragma unroll
        for (int a = 0; a < 2; ++a)
#pragma unroll
            for (int b = 0; b < 2; ++b)
#pragma unroll
                for (int m = 0; m < 4; ++m)
#pragma unroll
                    for (int n = 0; n < 2; ++n) acc[a][b][m][n] = (f32x4){0.f, 0.f, 0.f, 0.f};
        cur = nxt; cA = nA; cB = nB; ++ui;
        if constexpr (ALIGN_EPI) { if (wr == 1) PG8_BAR; }
    }
    PG8_WAIT_V(0);
    if constexpr (!ALIGN_EPI) { if (wr == 0) PG8_BAR; }
    PG8_BAR;
#undef PG8_SA
#undef PG8_SB
#undef PG8_STAGE
#undef PG8_LDA
#undef PG8_LDB
#undef PG8_MMA
#undef PG8_WAIT_V
#undef PG8_WAIT_L
#undef PG8_BAR
#undef PG8_SCHED
}

typedef f32x4 Acc[2][2][4][2];

struct EpiSwiGLU {
    static constexpr bool PERM = true;
    bf16_t* H;
    __device__ __forceinline__ void operator()(const Acc& acc, const Unit& u, int wr, int wc, int fr, int fq) const {
        bf16_t* hp = H + (((size_t)u.pm * HKT + 2 * u.pn + (wc >> 1)) * 256 + wr * 64 + fr) * 64 + (wc & 1) * 32 + 8 * fq;
#pragma unroll
        for (int ai = 0; ai < 2; ++ai)
#pragma unroll
            for (int m = 0; m < 4; ++m) {
                const f32x4 g0 = acc[ai][0][m][0], g1 = acc[ai][0][m][1], u0 = acc[ai][1][m][0], u1 = acc[ai][1][m][1];
                float h[8];
#pragma unroll
                for (int j = 0; j < 4; ++j) { h[j] = g0[j] * fast_sigmoid(g0[j]) * u0[j]; h[4 + j] = g1[j] * fast_sigmoid(g1[j]) * u1[j]; }
                u32x4 w; w.x = cvt_pk_bf16(h[0], h[1]); w.y = cvt_pk_bf16(h[2], h[3]); w.z = cvt_pk_bf16(h[4], h[5]); w.w = cvt_pk_bf16(h[6], h[7]);
                *(u32x4*)(hp + (size_t)(ai * HALF + m * 16) * 64) = w;
            }
    }
};
template <bool LNIN> struct EpiResid {
    static constexpr bool PERM = false;
    const float* res_lat; const float* res_ctx; float* X; const float* gate_tab; float gscale;
    const float* stats; const float* lng; const float* lnb;
    float* part;
    __device__ __forceinline__ void operator()(const Acc& acc, const Unit& u, int wr, int wc, int fr, int fq) const {
        if (u.part >= 0) {
            float* pb = part + ((size_t)u.part * TC + (size_t)(u.pm - 128) * BM + wr * 64 + fr) * D + u.pn * BM + wc * 32 + 4 * fq;
#pragma unroll
            for (int ai = 0; ai < 2; ++ai)
#pragma unroll
                for (int m = 0; m < 4; ++m)
#pragma unroll
                    for (int bj = 0; bj < 2; ++bj)
#pragma unroll
                        for (int n = 0; n < 2; ++n) *(f32x4*)(pb + (size_t)(ai * HALF + m * 16) * D + bj * HALF + n * 16) = acc[ai][bj][m][n];
            return;
        }
        const int bidx = u.pm < 128 ? (u.pm >> 4) : 8;
        const int r0 = wr * 64 + fr, col0 = u.pn * BM + wc * 32 + 4 * fq;
        const float* gate = gate_tab + (size_t)bidx * NMOD + col0;
        const float* rbase = (u.pm < 128 ? res_lat + (size_t)u.pm * BM * D : res_ctx + (size_t)(u.pm - 128) * BM * D) + (size_t)r0 * D + col0;
        float* xbase = X + ((size_t)u.pm * BM + r0) * D + col0;
        const float* stp = stats + ((size_t)u.pm * BM + r0) * 2;
#pragma unroll
        for (int bj = 0; bj < 2; ++bj)
#pragma unroll
            for (int n = 0; n < 2; ++n) {
                const int co = bj * HALF + n * 16;
                const f32x4 gv = *(const f32x4*)(gate + co) * gscale;
                f32x4 ga = (f32x4){ALPHA, ALPHA, ALPHA, ALPHA}, ba = (f32x4){0.f, 0.f, 0.f, 0.f};
                if constexpr (LNIN) { ga = *(const f32x4*)(lng + col0 + co) * ALPHA; ba = *(const f32x4*)(lnb + col0 + co) * ALPHA; }
#pragma unroll
                for (int ai = 0; ai < 2; ++ai)
#pragma unroll
                    for (int m = 0; m < 4; ++m) { const int rr = ai * HALF + m * 16; const size_t ro = (size_t)rr * D + co;
                        f32x4 r = *(const f32x4*)(rbase + ro);
                        if constexpr (LNIN) { const f32x2 st = *(const f32x2*)(stp + rr * 2); r = (r - st.x) * st.y; }
                        *(f32x4*)(xbase + ro) = r * ga + ba + gv * acc[ai][bj][m][n]; }
                asm volatile("" ::: "memory"); }
    }
};
struct EpiQK {
    static constexpr bool PERM = true;
    bf16_t* Q; bf16_t* Kb; const float* tab;
    __device__ __forceinline__ void operator()(const Acc& acc, const Unit& u, int wr, int wc, int fr, int fq) const {
        const bool is_q = u.pn < 8, lat = u.pm < 128;
        bf16_t* dst = is_q ? Q : Kb;
        const int col0 = (u.pn & 7) * BM + wc * 32 + 8 * fq, row0 = u.pm * BM + wr * 64 + fr;
        const float sc = is_q ? QSCALE : 1.0f;
        const int ax = wc & 1;
#pragma unroll
        for (int ai = 0; ai < 2; ++ai) {
            const int prow = (4 * u.pm + 2 * ai + wr) & 63;
#pragma unroll
            for (int m = 0; m < 4; ++m) {
                const int pos = ax ? (16 * m + fr) : prow;
                f32x4 t0 = (f32x4){1.f, 0.f, 1.f, 0.f}, t1 = t0;
                if (lat) { const float* tp = tab + (size_t)(pos * 16 + 4 * fq) * 2; t0 = *(const f32x4*)tp; t1 = *(const f32x4*)(tp + 4); }
#pragma unroll
                for (int bj = 0; bj < 2; ++bj) {
                    const f32x4 v0 = acc[ai][bj][m][0], v1 = acc[ai][bj][m][1];
                    float o[8];
                    o[0] = v0[0] * t0[0] - v0[1] * t0[1]; o[1] = v0[0] * t0[1] + v0[1] * t0[0];
                    o[2] = v0[2] * t0[2] - v0[3] * t0[3]; o[3] = v0[2] * t0[3] + v0[3] * t0[2];
                    o[4] = v1[0] * t1[0] - v1[1] * t1[1]; o[5] = v1[0] * t1[1] + v1[1] * t1[0];
                    o[6] = v1[2] * t1[2] - v1[3] * t1[3]; o[7] = v1[2] * t1[3] + v1[3] * t1[2];
                    u32x4 w; w.x = cvt_pk_bf16(o[0] * sc, o[1] * sc); w.y = cvt_pk_bf16(o[2] * sc, o[3] * sc); w.z = cvt_pk_bf16(o[4] * sc, o[5] * sc); w.w = cvt_pk_bf16(o[6] * sc, o[7] * sc);
                    *(u32x4*)(dst + (size_t)(row0 + ai * HALF + m * 16) * D + col0 + bj * HALF) = w;
                }
            }
        }
    }
};
struct EpiBf16 {
    static constexpr bool PERM = true;
    bf16_t* O; int ldc;
    __device__ __forceinline__ void operator()(const Acc& acc, const Unit& u, int wr, int wc, int fr, int fq) const {
        const int row0 = u.pm * BM + wr * 64 + fr, col0 = u.pn * BM + wc * 32 + 8 * fq;
#pragma unroll
        for (int ai = 0; ai < 2; ++ai)
#pragma unroll
            for (int m = 0; m < 4; ++m) { bf16_t* rowp = O + (size_t)(row0 + ai * HALF + m * 16) * ldc + col0;
#pragma unroll
                for (int bj = 0; bj < 2; ++bj) { const f32x4 v0 = acc[ai][bj][m][0], v1 = acc[ai][bj][m][1];
                    u32x4 w; w.x = cvt_pk_bf16(v0[0], v0[1]); w.y = cvt_pk_bf16(v0[2], v0[3]); w.z = cvt_pk_bf16(v1[0], v1[1]); w.w = cvt_pk_bf16(v1[2], v1[3]);
                    *(u32x4*)(rowp + bj * HALF) = w; } }
    }
};
struct EpiWin {
    static constexpr bool PERM = true;
    bf16_t* GG; bf16_t* XR;
    __device__ __forceinline__ void operator()(const Acc& acc, const Unit& u, int wr, int wc, int fr, int fq) const {
        const bool isg = u.pn < 10;
        bf16_t* dst = isg ? GG : XR;
        const int row0 = u.pm * BM + wr * 64 + fr, col0 = (isg ? u.pn : u.pn - 10) * BM + wc * 32 + 8 * fq;
#pragma unroll
        for (int ai = 0; ai < 2; ++ai)
#pragma unroll
            for (int m = 0; m < 4; ++m) { bf16_t* rowp = dst + (size_t)(row0 + ai * HALF + m * 16) * DR + col0;
#pragma unroll
                for (int bj = 0; bj < 2; ++bj) { f32x4 v0 = acc[ai][bj][m][0], v1 = acc[ai][bj][m][1];
                    if (isg) {
#pragma unroll
                        for (int j = 0; j < 4; ++j) { const float x = v0[j], y = v1[j];
                            v0[j] = x * fast_sigmoid(1.5957691216057308f * (x + 0.044715f * x * x * x));
                            v1[j] = y * fast_sigmoid(1.5957691216057308f * (y + 0.044715f * y * y * y)); } }
                    u32x4 w; w.x = cvt_pk_bf16(v0[0], v0[1]); w.y = cvt_pk_bf16(v0[2], v0[3]); w.z = cvt_pk_bf16(v1[0], v1[1]); w.w = cvt_pk_bf16(v1[2], v1[3]);
                    *(u32x4*)(rowp + bj * HALF) = w; } }
    }
};
struct EpiGates {
    static constexpr bool PERM = true;
    const bf16_t* XC; const float* ba; const float* bi; const float* c8; unsigned short* AB; int q;
    __device__ __forceinline__ void operator()(const Acc& acc, const Unit& u, int wr, int wc, int fr, int fq) const {
        const int d = u.pn / 20, blk = (u.pn % 20) >> 1, half = u.pn & 1;
        const int ch0 = blk * 256 + half * 128 + wc * 32 + 8 * fq;
        const int gp = u.pm < 32 ? 32 * q + u.pm : 128 + 2 * q + (u.pm - 32);
        const int r0 = wr * 64 + fr;
        const bf16_t* xcp = XC + ((size_t)gp * BM + r0) * DR + ch0;
        unsigned short* A1 = AB + (size_t)(2 * d) * ((size_t)QROWS * DR) + ((size_t)u.pm * BM + r0) * DR + ch0;
        unsigned short* Bq = A1 + (size_t)QROWS * DR;
#pragma unroll
        for (int n = 0; n < 2; ++n) {
            const f32x4 bav = *(const f32x4*)(ba + d * DR + ch0 + 4 * n), biv = *(const f32x4*)(bi + d * DR + ch0 + 4 * n), cv = *(const f32x4*)(c8 + d * DR + ch0 + 4 * n);
#pragma unroll
            for (int ai = 0; ai < 2; ++ai)
#pragma unroll
                for (int m = 0; m < 4; ++m) {
                    const size_t ro = (size_t)(ai * HALF + m * 16) * DR + 4 * n;
                    const u32x2 xw = *(const u32x2*)(xcp + ro);
                    const float xc[4] = {bf_lo(xw.x), bf_hi(xw.x), bf_lo(xw.y), bf_hi(xw.y)};
                    f32x4 ga = acc[ai][0][m][n], gi = acc[ai][1][m][n];
                    asm volatile("" : "+v"(ga), "+v"(gi));
                    float am[4], bb[4];
#pragma unroll
                    for (int j = 0; j < 4; ++j) {
                        const float r = fast_sigmoid(ga[j] + bav[j]), ig = fast_sigmoid(gi[j] + biv[j]);
                        const float a = __builtin_amdgcn_exp2f(r * cv[j] * LOG2E);
                        const float a1 = 1.0f - a;
                        am[j] = a1; bb[j] = __builtin_sqrtf(a1 * (1.0f + a)) * ig * xc[j];
                    }
                    u32x2 wa, wb;
                    wa.x = pk_f16(am[0], am[1]); wa.y = pk_f16(am[2], am[3]); wb.x = pk_f16(bb[0], bb[1]); wb.y = pk_f16(bb[2], bb[3]);
                    *(u32x2*)(A1 + ro) = wa; *(u32x2*)(Bq + ro) = wb;
                    asm volatile("" ::: "memory");
                }
        }
    }
};
}

struct Params {
    const float* in[27];
    float* out;
    unsigned char* ws;
};

#define KAS __attribute__((address_space(4)))
__device__ __forceinline__ const float* ldparam(int k) { const KAS char* kp = (const KAS char*)__builtin_amdgcn_kernarg_segment_ptr(); asm volatile("" : "+s"(kp)); return *(const float* const KAS*)(kp + 8 * k); }
#define PIN(k) ldparam(k)
#define POUT() ((float*)ldparam(27))

struct Ctx {
    LAS unsigned char* lds;
    unsigned char* ws;
    int tid, lane, wave, vcu, G;
};

__device__ __forceinline__ int opaque_tid() { int t = threadIdx.x; asm volatile("" : "+v"(t)); return t; }
__device__ __forceinline__ Ctx fresh(const Ctx& C0) { Ctx R = C0; const int t = opaque_tid(); R.tid = t; R.lane = t & 63; R.wave = __builtin_amdgcn_readfirstlane(t >> 6); return R; }

template <bool QKPERM, int TKT = 0>
__device__ __forceinline__ void transpose_item(const float* W, int ldw, int k0, int n0, bf16_t* WT, int ldo, int orow0, LAS float* scr, int lane) {
    f32x4 ld[8];
#pragma unroll
    for (int i = 0; i < 8; ++i) ld[i] = *(const f32x4*)(W + (size_t)(k0 + 8 * i + (lane >> 3)) * ldw + n0 + 4 * (lane & 7));
#pragma unroll
    for (int i = 0; i < 8; ++i) { LAS float* d = scr + (8 * i + (lane >> 3)) * 33 + 4 * (lane & 7); d[0] = ld[i][0]; d[1] = ld[i][1]; d[2] = ld[i][2]; d[3] = ld[i][3]; }
    asm volatile("s_waitcnt lgkmcnt(0)" ::: "memory");
    const int c = lane & 7;
#pragma unroll
    for (int j = 0; j < 4; ++j) { const int n = (lane >> 3) + 8 * j; const LAS float* s = scr + (8 * c) * 33 + n;
        u32x4 o; o.x = pk2(s[0 * 33], s[1 * 33]); o.y = pk2(s[2 * 33], s[3 * 33]); o.z = pk2(s[4 * 33], s[5 * 33]); o.w = pk2(s[6 * 33], s[7 * 33]);
        const int np = QKPERM ? (2 * (n & 15) + (n >> 4)) : n;
        if constexpr (TKT > 0) { const int orow = orow0 + np; *(u32x4*)(WT + ((size_t)((orow >> 8) * TKT + (k0 >> 6)) * 256 + (orow & 255)) * 64 + 8 * c) = o; }
        else *(u32x4*)(WT + (size_t)(orow0 + np) * ldo + k0 + 8 * c) = o; }
    asm volatile("s_waitcnt lgkmcnt(0)" ::: "memory");
}

namespace wc {
constexpr int I_G = 32 * 176, I_D = 88 * 64, I_QK = 32 * 128, I_V = 32 * 64, I_O = 32 * 64, I_IN = 32 * 160, I_A = 20 * 32, I_OUT = 40 * 64;
constexpr int GU0 = 0, WD0 = 8 * I_G, ATT0 = WD0 + 4 * I_D, LRU0 = ATT0 + I_QK + I_V + I_O, NITEMS = LRU0 + I_IN + 2 * I_A + I_OUT;
}
__device__ __forceinline__ void convert_weights(const Ctx& C0, const Params& P, int lo, int hi, int widx, int wcount) {
    const Ctx C = fresh(C0);
    using namespace wc;
    LAS float* scr = (LAS float*)(C.lds + C.wave * 16384);
    bf16_t* Wgu = (bf16_t*)(C.ws + WS_WGU); bf16_t* Wd = (bf16_t*)(C.ws + WS_WD);
    for (int it = lo + widx; it < hi; it += wcount) {
        int r = it;
        if (r < 8 * I_G) {
            const int lf = r / (2 * I_G); r -= lf * 2 * I_G; const int which = r / I_G; r -= which * I_G;
            const int kb = r / 176, nb = r % 176, n0 = nb * 32;
            const float* W = (which ? PIN(9) : PIN(8)) + (size_t)lf * D * FF;
            transpose_item<false, 32>(W, FF, kb * 64, n0, Wgu + (size_t)lf * 11264 * WP2, WP2, 256 * (n0 >> 7) + (n0 & 127) + which * 128, scr, C.lane);
            continue; }
        r -= 8 * I_G;
        if (r < 4 * I_D) { const int lf = r / I_D; r -= lf * I_D; const int kb = r / 64, nb = r % 64;
            transpose_item<false, 88>(PIN(10) + (size_t)lf * FF * D, D, kb * 64, nb * 32, Wd + (size_t)lf * D * WP5, WP5, nb * 32, scr, C.lane); continue; }
        r -= 4 * I_D;
        if (r < I_QK) { const int kb = r / 128, nb = r % 128;
            transpose_item<true>(PIN(11), 3 * D, kb * 64, nb * 32, (bf16_t*)(C.ws + WS_WQK), WP2, nb * 32, scr, C.lane); continue; }
        r -= I_QK;
        if (r < I_V) { const int kb = r / 64, nb = r % 64;
            transpose_item<false>(PIN(11), 3 * D, kb * 64, 2 * D + nb * 32, (bf16_t*)(C.ws + WS_WV), WP2, nb * 32, scr, C.lane); continue; }
        r -= I_V;
        if (r < I_O) { const int kb = r / 64, nb = r % 64;
            transpose_item<false>(PIN(12), D, kb * 64, nb * 32, (bf16_t*)(C.ws + WS_WO), WP2, nb * 32, scr, C.lane); continue; }
        r -= I_O;
        if (r < I_IN) { const int kb = r / 160, nb = r % 160;
            transpose_item<false>(PIN(18), 2 * DR, kb * 64, nb * 32, (bf16_t*)(C.ws + WS_WIN), WP2, nb * 32, scr, C.lane); continue; }
        r -= I_IN;
        if (r < 2 * I_A) { const int which = r / I_A; r -= which * I_A; const int mat = r / 32; r -= mat * 32; const int kb = r / 8, nb = r % 8, n0 = nb * 32;
            const float* W = (which ? PIN(23) : PIN(21)) + (size_t)mat * 256 * 256;
            transpose_item<false>(W, 256, kb * 64, n0, (bf16_t*)(C.ws + WS_WAI), 256, (mat * 2 + (n0 >> 7)) * 256 + (n0 & 127) + which * 128, scr, C.lane); continue; }
        r -= 2 * I_A;
        { const int kb = r / 64, nb = r % 64;
            transpose_item<false>(PIN(26), D, kb * 64, nb * 32, (bf16_t*)(C.ws + WS_WOUT), WPR, nb * 32, scr, C.lane); }
    }
}

__device__ __forceinline__ void convert_in_tail(const Ctx& C, const Params& P, int nunits, int lo, int hi) {
    const int rem = nunits % C.G, cid = (int)blockIdx.x;
    if (rem == 0) convert_weights(C, P, lo, hi, cid * 8 + C.wave, C.G * 8);
    else if (cid >= rem) convert_weights(C, P, lo, hi, (cid - rem) * 8 + C.wave, (C.G - rem) * 8);
}

__device__ __forceinline__ void prologue_mod(const Ctx& C0, const Params& P, int layer, int wgi, int wgn) {
    const Ctx C = fresh(C0);
    LAS float* sc = (LAS float*)C.lds;
    LAS float* red = (LAS float*)(C.lds + 9 * 2048 * 4);
    for (int idx = C.tid; idx < 9 * D; idx += 512) { const int bidx = idx >> 11, k = idx & 2047; const float cv = bidx < 8 ? PIN(1)[bidx * D + k] : PIN(3)[k]; sc[idx] = cv / (1.0f + __expf(-cv)); }
    __syncthreads();
    float* MOD = (float*)(C.ws + WS_MOD);
    for (int item = wgi; item < 144; item += wgn) {
        const int n0 = item * 128;
        const float* W = PIN(4) + (size_t)layer * D * NMOD + n0 + 2 * C.lane;
        float a0[9], a1[9];
#pragma unroll
        for (int b = 0; b < 9; ++b) { a0[b] = 0.f; a1[b] = 0.f; }
        const int kbeg = C.wave * 256;
#pragma unroll 8
        for (int k = kbeg; k < kbeg + 256; ++k) {
            const f32x2 w = *(const f32x2*)(W + (size_t)k * NMOD);
#pragma unroll
            for (int b = 0; b < 9; ++b) { const float s = sc[b * 2048 + k]; a0[b] += s * w.x; a1[b] += s * w.y; }
        }
#pragma unroll
        for (int b = 0; b < 9; ++b) { red[(C.wave * 9 + b) * 128 + 2 * C.lane] = a0[b]; red[(C.wave * 9 + b) * 128 + 2 * C.lane + 1] = a1[b]; }
        __syncthreads();
        for (int idx = C.tid; idx < 9 * 128; idx += 512) { const int b = idx >> 7, col = idx & 127; float s = 0.f;
#pragma unroll
            for (int w = 0; w < 8; ++w) s += red[(w * 9 + b) * 128 + col];
            MOD[((size_t)layer * 9 + b) * NMOD + n0 + col] = s + PIN(5)[layer * NMOD + n0 + col]; }
        __syncthreads();
    }
}

__device__ __forceinline__ void prologue_small(const Ctx& C0, const Params& P) {
    const Ctx C = fresh(C0);
    if (C.vcu == 0) {
        float* tab = (float*)(C.ws + WS_TAB);
        for (int idx = C.tid; idx < 64 * 16; idx += 512) { const int pos = idx >> 4, j = idx & 15;
            const float inv = powf(10000.0f, -(float)(2 * j) / 32.0f); const float ang = (float)pos * inv;
            tab[2 * idx] = cosf(ang); tab[2 * idx + 1] = sinf(ang); }
        if (C.tid == 0) { float s1 = 0.f, s2 = 0.f; for (int i = 0; i < 64; ++i) { s1 += PIN(13)[i] * PIN(14)[i]; s2 += PIN(15)[i] * PIN(16)[i]; }
            *(float*)(C.ws + WS_LAM) = expf(s1) - expf(s2) + 0.2f; }
    }
    if (C.vcu == 1) {
        float* c8 = (float*)(C.ws + WS_C8);
        for (int idx = C.tid; idx < 2 * DR; idx += 512) { const float ap = PIN(25)[idx]; c8[idx] = -8.0f * log1pf(expf(-ap)); }
    }
}

__device__ __forceinline__ void prep_phase(const Ctx& C0, const Params& P) {
    const Ctx C = fresh(C0);
    const float* MOD = (const float*)(C.ws + WS_MOD);
    bf16_t* U = (bf16_t*)(C.ws + WS_U);
    const int gw = C.vcu * 8 + C.wave, NGW = C.G * 8;
    for (int row = gw; row < T; row += NGW) {
        const int bidx = row < TL ? (row >> 12) : 8;
        const float* xr = (row < TL ? PIN(0) + (size_t)row * D : PIN(2) + (size_t)(row - TL) * D) + 4 * C.lane;
        const float* sh = MOD + (size_t)bidx * NMOD + 4 * C.lane; const float* scl = sh + D;
#pragma unroll
        for (int j = 0; j < 8; ++j) { const f32x4 v = *(const f32x4*)(xr + 256 * j), s = *(const f32x4*)(sh + 256 * j), c = *(const f32x4*)(scl + 256 * j);
            const f32x4 o = v * (c + 1.0f) + s; u32x2 w; w.x = cvt_pk_bf16(o[0], o[1]); w.y = cvt_pk_bf16(o[2], o[3]);
            *(u32x2*)(U + (size_t)row * D + 256 * j + 4 * C.lane) = w; }
    }
}

struct CtxComb { const float* part; const float* res_raw; const float* pg; const float* pb; const float* gate; float gscale; bool on; };
__device__ __forceinline__ void ln_phase(const Ctx& C0, int M, const float* lng, const float* lnb, const float* modn  , bf16_t* U, float* out, const CtxComb cc) {
    const Ctx C = fresh(C0);
    float* X = (float*)(C.ws + WS_X);
    f32x2* ST = (f32x2*)(C.ws + WS_STATS);
    const int gw = C.vcu * 8 + C.wave, NGW = C.G * 8;
    f32x4 g[8], b[8];
#pragma unroll
    for (int j = 0; j < 8; ++j) { g[j] = *(const f32x4*)(lng + 256 * j + 4 * C.lane); b[j] = *(const f32x4*)(lnb + 256 * j + 4 * C.lane); }
    for (int row = gw; row < M; row += NGW) {
        float* xr = X + (size_t)row * D + 4 * C.lane;
        f32x4 v[8]; float s = 0.f;
        if (cc.on && row >= TL) {
            const size_t co = (size_t)(row - TL) * D + 4 * C.lane;
            f32x2 ost = (f32x2){0.f, 1.f}; if (!cc.res_raw) ost = ST[row];
#pragma unroll
            for (int j = 0; j < 8; ++j) { const float* pp = cc.part + co + 256 * j;
                const f32x4 sum = (*(const f32x4*)pp + *(const f32x4*)(pp + (size_t)TC * D)) + (*(const f32x4*)(pp + (size_t)2 * TC * D) + *(const f32x4*)(pp + (size_t)3 * TC * D));
                f32x4 r;
                if (cc.res_raw) r = *(const f32x4*)(cc.res_raw + co + 256 * j);
                else r = (*(const f32x4*)(xr + 256 * j) - ost.x) * ost.y * *(const f32x4*)(cc.pg + 256 * j + 4 * C.lane) + *(const f32x4*)(cc.pb + 256 * j + 4 * C.lane);
                v[j] = r * ALPHA + *(const f32x4*)(cc.gate + 256 * j + 4 * C.lane) * cc.gscale * sum;
                *(f32x4*)(xr + 256 * j) = v[j]; }
        } else {
#pragma unroll
            for (int j = 0; j < 8; ++j) v[j] = *(const f32x4*)(xr + 256 * j);
        }
#pragma unroll
        for (int j = 0; j < 8; ++j) s += (v[j][0] + v[j][1]) + (v[j][2] + v[j][3]);
        const float mean = wave_sum(s) * (1.0f / D); float s2 = 0.f;
#pragma unroll
        for (int j = 0; j < 8; ++j) { v[j] = v[j] - mean; s2 += (v[j][0] * v[j][0] + v[j][1] * v[j][1]) + (v[j][2] * v[j][2] + v[j][3] * v[j][3]); }
        const float rstd = 1.0f / sqrtf(wave_sum(s2) * (1.0f / D) + LN_EPS);
        if (C.lane == 0) ST[row] = (f32x2){mean, rstd};
#pragma unroll
        for (int j = 0; j < 8; ++j) v[j] = v[j] * rstd * g[j] + b[j];
        if (out) {
#pragma unroll
            for (int j = 0; j < 8; ++j) *(f32x4*)(out + (size_t)row * D + 256 * j + 4 * C.lane) = v[j];
        }
        if (modn) {
            const int bidx = row < TL ? (row >> 12) : 8;
            const float* sh = modn + (size_t)bidx * NMOD + 4 * C.lane; const float* scl = sh + D;
#pragma unroll
            for (int j = 0; j < 8; ++j) { const f32x4 s4 = *(const f32x4*)(sh + 256 * j), c4 = *(const f32x4*)(scl + 256 * j);
                const f32x4 o = v[j] * (c4 + 1.0f) + s4; u32x2 w; w.x = cvt_pk_bf16(o[0], o[1]); w.y = cvt_pk_bf16(o[2], o[3]);
                *(u32x2*)(U + (size_t)row * D + 256 * j + 4 * C.lane) = w; }
        }
    }
}

namespace att {
constexpr int SLOT = 16384, LDS_K = 0, LDS_V = 4 * SLOT;
#define ATT_SBAR() __builtin_amdgcn_sched_barrier(0)
__device__ __forceinline__ float rowmax32(const f32x16& a, const f32x16& b) {
    float x = __builtin_fmaxf(__builtin_fmaxf(a[0], a[1]), b[0]), y = __builtin_fmaxf(__builtin_fmaxf(a[2], a[3]), b[1]);
    x = __builtin_fmaxf(__builtin_fmaxf(x, b[2]), b[3]);
#pragma unroll
    for (int r = 4; r < 16; r += 4) { x = __builtin_fmaxf(__builtin_fmaxf(x, a[r]), a[r + 1]); y = __builtin_fmaxf(__builtin_fmaxf(y, a[r + 2]), a[r + 3]); x = __builtin_fmaxf(__builtin_fmaxf(x, b[r]), b[r + 1]); y = __builtin_fmaxf(__builtin_fmaxf(y, b[r + 2]), b[r + 3]); }
    float m = __builtin_fmaxf(x, y);
    auto rr = __builtin_amdgcn_permlane32_swap(__float_as_uint(m), __float_as_uint(m), false, false);
    return __builtin_fmaxf(__uint_as_float(rr[0]), __uint_as_float(rr[1]));
}
__device__ __forceinline__ float halfsum(float x) { auto rr = __builtin_amdgcn_permlane32_swap(__float_as_uint(x), __float_as_uint(x), false, false); return __uint_as_float(rr[0]) + __uint_as_float(rr[1]); }
__device__ __forceinline__ void unit(const Ctx& C, const bf16_t* Q, const bf16_t* Kb, const bf16_t* VT, bf16_t* O, int qrow0, int h, int NT, int krow_ctx, int krow_lat, const float* lamp, const float* subg) {
    int lane = (int)(threadIdx.x & 63u); asm volatile("" : "+v"(lane));
    const int wid = __builtin_amdgcn_readfirstlane((int)(threadIdx.x >> 6)), l32 = lane & 31, hi = lane >> 5, qsub = wid >> 1, e = wid & 1;
    LAS unsigned char* lds = C.lds;
    unsigned koffl[2], voffl[2];
#pragma unroll
    for (int j = 0; j < 2; ++j) { const int p = 2 * wid + j;
        { const int r = 4 * p + (lane >> 4), c = (lane & 15) ^ (r & 15); koffl[j] = (unsigned)(r * D + h * 128 + c * 8) * 2u; }
        { const int v = 8 * p + (lane >> 3), c = (lane & 7) ^ ((v >> 1) & 7); voffl[j] = (unsigned)((h * 128 + v) * T + c * 8) * 2u; } }
#define ATT_KROW(t) ((t) < 4 ? krow_ctx + 64 * (t) : krow_lat + 64 * ((t) - 4))
#define ATT_DMA_K(t, slot) do { const char* b_ = (const char*)Kb + (size_t)ATT_KROW(t) * (D * 2); const int d_ = LDS_K + (slot) * SLOT + wid * 2048; \
        __builtin_amdgcn_global_load_lds((const unsigned*)(b_ + koffl[0]), (LAS unsigned*)(lds + d_), 16, 0, 0); \
        __builtin_amdgcn_global_load_lds((const unsigned*)(b_ + koffl[1]), (LAS unsigned*)(lds + d_ + 1024), 16, 0, 0); } while (0)
#define ATT_DMA_V(t, slotoff) do { const char* b_ = (const char*)VT + (size_t)ATT_KROW(t) * 2; const int d_ = LDS_V + (slotoff) + wid * 2048; \
        __builtin_amdgcn_global_load_lds((const unsigned*)(b_ + voffl[0]), (LAS unsigned*)(lds + d_), 16, 0, 0); \
        __builtin_amdgcn_global_load_lds((const unsigned*)(b_ + voffl[1]), (LAS unsigned*)(lds + d_ + 1024), 16, 0, 0); } while (0)
#define ATT_WAIT_BAR(N) do { asm volatile("" ::: "memory"); __builtin_amdgcn_s_waitcnt(0x0070 | (N)); asm volatile("s_barrier" ::: "memory"); } while (0)
    bf16x8 qf[4];
    { const bf16_t* qp = Q + (size_t)(qrow0 + 32 * qsub + l32) * D + h * 128 + e * 64 + 8 * hi;
#pragma unroll
      for (int ds = 0; ds < 4; ++ds) qf[ds] = *(const bf16x8*)(qp + 16 * ds); }
    ATT_DMA_K(0, 0); ATT_DMA_K(1, 1); ATT_DMA_K(2, 2); ATT_DMA_V(0, 0); ATT_DMA_K(3, 3); ATT_DMA_V(1, SLOT);
    const int pil = (l32 & ~12) | ((l32 & 4) << 1) | ((l32 & 8) >> 1);
    int kofs[4], vofs[4];
#pragma unroll
    for (int ds = 0; ds < 4; ++ds) kofs[ds] = LDS_K + pil * 256 + (((e * 8 + ds * 2 + hi) ^ (pil & 15)) << 4);
#pragma unroll
    for (int ks = 0; ks < 4; ++ks) vofs[ks] = LDS_V + l32 * 128 + (((2 * ks + hi) ^ ((l32 >> 1) & 7)) << 4);
#define ATT_KLD(dst, slot) do { _Pragma("unroll") for (int ds_ = 0; ds_ < 4; ++ds_) { dst[2 * ds_] = *(const LAS bf16x8*)(lds + (slot) * SLOT + kofs[ds_]); dst[2 * ds_ + 1] = *(const LAS bf16x8*)(lds + (slot) * SLOT + kofs[ds_] + 8192); } } while (0)
    f32x16 o[4];
#pragma unroll
    for (int vt = 0; vt < 4; ++vt)
#pragma unroll
        for (int r = 0; r < 16; ++r) o[vt][r] = 0.f;
    f32x16 negm;
    float mrow = 0.f, lsum = 0.f;
    bf16x8 kf[8];
    u32x4 pwA[4], pwB[4];
    f32x16 c0, c1;
    ATT_WAIT_BAR(8);
    ATT_KLD(kf, 0);
#pragma unroll
    for (int ds = 0; ds < 4; ++ds) { const f32x16 z16 = {0.f, 0.f, 0.f, 0.f, 0.f, 0.f, 0.f, 0.f, 0.f, 0.f, 0.f, 0.f, 0.f, 0.f, 0.f, 0.f};
        c0 = __builtin_amdgcn_mfma_f32_32x32x16_bf16(kf[2 * ds], qf[ds], ds == 0 ? z16 : c0, 0, 0, 0); c1 = __builtin_amdgcn_mfma_f32_32x32x16_bf16(kf[2 * ds + 1], qf[ds], ds == 0 ? z16 : c1, 0, 0, 0); }
    ATT_KLD(kf, 1);
    { const float rm = rowmax32(c0, c1); mrow = rm;
#pragma unroll
      for (int r = 0; r < 16; ++r) negm[r] = -mrow;
      asm volatile("" : "+v"(negm));
      float ps = 0.f;
#pragma unroll
      for (int r = 0; r < 16; ++r) { c0[r] = __builtin_amdgcn_exp2f(c0[r] - rm); c1[r] = __builtin_amdgcn_exp2f(c1[r] - rm); ps += c0[r] + c1[r]; }
      lsum = ps;
      pwA[0] = (u32x4){cvt_pk_bf16(c0[0], c0[1]), cvt_pk_bf16(c0[2], c0[3]), cvt_pk_bf16(c0[4], c0[5]), cvt_pk_bf16(c0[6], c0[7])};
      pwA[1] = (u32x4){cvt_pk_bf16(c0[8], c0[9]), cvt_pk_bf16(c0[10], c0[11]), cvt_pk_bf16(c0[12], c0[13]), cvt_pk_bf16(c0[14], c0[15])};
      pwA[2] = (u32x4){cvt_pk_bf16(c1[0], c1[1]), cvt_pk_bf16(c1[2], c1[3]), cvt_pk_bf16(c1[4], c1[5]), cvt_pk_bf16(c1[6], c1[7])};
      pwA[3] = (u32x4){cvt_pk_bf16(c1[8], c1[9]), cvt_pk_bf16(c1[10], c1[11]), cvt_pk_bf16(c1[12], c1[13]), cvt_pk_bf16(c1[14], c1[15])}; }
    int vs_prev = 0, vs_cur = SLOT, vs_next = 2 * SLOT;
#define ATT_ROT() do { const int t_ = vs_prev; vs_prev = vs_cur; vs_cur = vs_next; vs_next = t_; } while (0)
#define ATT_PEL(i) ((i) < 16 ? c0[(i) & 15] : c1[(i) & 15])
#define ATT_GAPB(g, VT_, VF, PWC, PWN, CV) do { o[VT_] = __builtin_amdgcn_mfma_f32_32x32x16_bf16(VF, __builtin_bit_cast(bf16x8, PWC[(g) >> 2]), o[VT_], 0, 0, 0); \
        { const float a_ = __builtin_amdgcn_exp2f(CV[(2 * (g)) & 15]), b_ = __builtin_amdgcn_exp2f(CV[(2 * (g) + 1) & 15]); \
          CV[(2 * (g)) & 15] = a_; CV[(2 * (g) + 1) & 15] = b_; lacc += a_; lacc += b_; PWN[(g) >> 2][(g) & 3] = cvt_pk_bf16(a_, b_); } ATT_SBAR(); } while (0)
#define ATT_VLD(dst, ks_) do { _Pragma("unroll") for (int vt_ = 0; vt_ < 4; ++vt_) dst[vt_] = *(const LAS bf16x8*)(vp_ + vofs[ks_] + vt_ * 4096); } while (0)
#define ATT_KLDH(dst, slot, h_) do { _Pragma("unroll") for (int ds_ = 2 * (h_); ds_ < 2 * (h_) + 2; ++ds_) { dst[2 * ds_] = *(const LAS bf16x8*)(lds + (slot) * SLOT + kofs[ds_]); dst[2 * ds_ + 1] = *(const LAS bf16x8*)(lds + (slot) * SLOT + kofs[ds_] + 8192); } } while (0)
#define ATT_STEP(PWC, PWN, T_, KREAD) do { \
        ATT_WAIT_BAR(4); \
        const LAS unsigned char* vp_ = lds + vs_prev; \
        bf16x8 vf0[4], vf1[4]; \
        ATT_VLD(vf0, 0); \
        ATT_SBAR(); \
        _Pragma("unroll") for (int ds_ = 0; ds_ < 4; ++ds_) { c0 = __builtin_amdgcn_mfma_f32_32x32x16_bf16(kf[2 * ds_], qf[ds_], ds_ == 0 ? negm : c0, 0, 0, 0); c1 = __builtin_amdgcn_mfma_f32_32x32x16_bf16(kf[2 * ds_ + 1], qf[ds_], ds_ == 0 ? negm : c1, 0, 0, 0); } \
        ATT_SBAR(); \
        { const int tk_ = (T_) + 3 < NT ? (T_) + 3 : NT - 1, tv_ = (T_) + 1 < NT ? (T_) + 1 : NT - 1; ATT_DMA_K(tk_, ((T_) + 3) & 3); ATT_DMA_V(tv_, vs_next); }     \
        ATT_SBAR(); \
        float fresc = 1.0f; bool resc = false; \
        { const float rm_ = rowmax32(c0, c1); \
          if (__builtin_expect(__any(rm_ > 8.0f), 0)) { const float dl_ = __builtin_fmaxf(rm_, 0.f); mrow += dl_; \
              _Pragma("unroll") for (int r_ = 0; r_ < 16; ++r_) { c0[r_] -= dl_; c1[r_] -= dl_; } \
              _Pragma("unroll") for (int r_ = 0; r_ < 16; ++r_) negm[r_] = -mrow; \
              asm volatile("" : "+v"(negm)); \
              fresc = __builtin_amdgcn_exp2f(-dl_); lsum *= fresc; resc = true; } } \
        ATT_SBAR(); \
        float lacc = 0.f; \
          \
        ATT_GAPB(0, 0, vf0[0], PWC, PWN, c0); ATT_VLD(vf1, 1); ATT_SBAR(); ATT_GAPB(1, 1, vf0[1], PWC, PWN, c0); ATT_GAPB(2, 2, vf0[2], PWC, PWN, c0); ATT_GAPB(3, 3, vf0[3], PWC, PWN, c0); \
        ATT_GAPB(4, 0, vf1[0], PWC, PWN, c0); ATT_VLD(vf0, 2); ATT_SBAR(); ATT_GAPB(5, 1, vf1[1], PWC, PWN, c0); ATT_GAPB(6, 2, vf1[2], PWC, PWN, c0); ATT_GAPB(7, 3, vf1[3], PWC, PWN, c0); \
        ATT_GAPB(8, 0, vf0[0], PWC, PWN, c1); ATT_VLD(vf1, 3); if (KREAD) { ATT_KLDH(kf, ((T_) + 1) & 3, 0); } ATT_SBAR(); ATT_GAPB(9, 1, vf0[1], PWC, PWN, c1); ATT_GAPB(10, 2, vf0[2], PWC, PWN, c1); ATT_GAPB(11, 3, vf0[3], PWC, PWN, c1); \
        ATT_GAPB(12, 0, vf1[0], PWC, PWN, c1); if (KREAD) { ATT_KLDH(kf, ((T_) + 1) & 3, 1); } ATT_SBAR(); ATT_GAPB(13, 1, vf1[1], PWC, PWN, c1); ATT_GAPB(14, 2, vf1[2], PWC, PWN, c1); ATT_GAPB(15, 3, vf1[3], PWC, PWN, c1); \
        lsum += lacc; \
        if (resc) { _Pragma("unroll") for (int vt_ = 0; vt_ < 4; ++vt_) _Pragma("unroll") for (int r_ = 0; r_ < 16; ++r_) o[vt_][r_] *= fresc; } \
        ATT_ROT(); \
    } while (0)
    int t = 1;
    for (; t + 2 < NT; t += 2) { ATT_STEP(pwA, pwB, t, true); ATT_STEP(pwB, pwA, t + 1, true); }
    ATT_STEP(pwA, pwB, t, false);
    ATT_WAIT_BAR(4);
    { const LAS unsigned char* vp_ = lds + vs_prev;
#pragma unroll
      for (int vt = 0; vt < 4; ++vt)
#pragma unroll
          for (int ks = 0; ks < 4; ++ks) { const bf16x8 vf = *(const LAS bf16x8*)(vp_ + vofs[ks] + vt * 4096);
              o[vt] = __builtin_amdgcn_mfma_f32_32x32x16_bf16(vf, __builtin_bit_cast(bf16x8, pwB[ks]), o[vt], 0, 0, 0); } }
    ATT_WAIT_BAR(0);
    const float ltot = halfsum(lsum);
    const float inv = 1.0f / ltot;
    LAS float* ex = (LAS float*)(lds + qsub * 16384);
    if (e == 1) {
        const float f = inv * *lamp;
#pragma unroll
        for (int vt = 0; vt < 4; ++vt)
#pragma unroll
            for (int r = 0; r < 16; ++r) { const int v = 32 * vt + (r & 3) + 8 * (r >> 2) + 4 * hi; ex[v * 32 + l32] = o[vt][r] * f; }
    }
    __syncthreads();
    if (e == 0) {
        float ss = 0.f;
#pragma unroll
        for (int vt = 0; vt < 4; ++vt)
#pragma unroll
            for (int r = 0; r < 16; ++r) { const int v = 32 * vt + (r & 3) + 8 * (r >> 2) + 4 * hi; const float d = o[vt][r] * inv - ex[v * 32 + l32]; o[vt][r] = d; ss += d * d; }
        ss = halfsum(ss);
        const float rs = 0.8f / sqrtf(ss * (1.0f / 128.0f) + LN_EPS);
        asm volatile("s_waitcnt lgkmcnt(0)" ::: "memory");
        LAS unsigned char* st = (LAS unsigned char*)ex;
        const float* sgp = subg; asm volatile("" : "+s"(sgp));
#pragma unroll
        for (int vt = 0; vt < 4; ++vt)
#pragma unroll
            for (int rg = 0; rg < 4; ++rg) { const int v = 32 * vt + 8 * rg + 4 * hi; const f32x4 gg = *(const f32x4*)(sgp + v);
                u32x2 w; w.x = cvt_pk_bf16(o[vt][4 * rg] * rs * gg[0], o[vt][4 * rg + 1] * rs * gg[1]); w.y = cvt_pk_bf16(o[vt][4 * rg + 2] * rs * gg[2], o[vt][4 * rg + 3] * rs * gg[3]);
                *(LAS u32x2*)(st + l32 * 272 + v * 2) = w; }
        asm volatile("s_waitcnt lgkmcnt(0)" ::: "memory");
#pragma unroll
        for (int i = 0; i < 8; ++i) { const int c = lane + 64 * i, row = c >> 4, cg = c & 15;
            const u32x4 v = *(const LAS u32x4*)(st + row * 272 + cg * 16);
            *(u32x4*)(O + (size_t)(qrow0 + 32 * qsub + row) * D + h * 128 + cg * 8) = v; }
    }
    asm volatile("s_waitcnt vmcnt(0)" ::: "memory");
    __syncthreads();
#undef ATT_KROW
#undef ATT_DMA_K
#undef ATT_DMA_V
#undef ATT_WAIT_BAR
#undef ATT_KLD
#undef ATT_ROT
#undef ATT_PEL
#undef ATT_GAPB
#undef ATT_VLD
#undef ATT_KLDH
#undef ATT_STEP
}
}

__device__ __forceinline__ void attn_phase(const Ctx& C, const float* subg) {
    const bf16_t* Q = (const bf16_t*)(C.ws + WS_Q); const bf16_t* Kb = (const bf16_t*)(C.ws + WS_K); const bf16_t* VT = (const bf16_t*)(C.ws + WS_VT);
    bf16_t* O = (bf16_t*)(C.ws + WS_O);
    const float* lamp = (const float*)(C.ws + WS_LAM);
    const int bx = blockIdx.x, G = C.G;
    for (int i = 0; i * G + bx < 4096; ++i) {
        const int uidx = i * G + bx;
        const int bh = (G == 256) ? (bx & 7) + 8 * i : (uidx >> 5), qb = (G == 256) ? (bx >> 3) : (uidx & 31);
        const int b = bh >> 4, h = bh & 15;
        att::unit(C, Q, Kb, VT, O, b * SEQ + qb * 128, h, 68, TL + b * CTXL, b * SEQ, lamp, subg);
    }
    for (int uidx = bx; uidx < 256; uidx += G) { const int bh = uidx >> 1, b = bh >> 4, h = bh & 15;
        att::unit(C, Q, Kb, VT, O, TL + b * CTXL + (uidx & 1) * 128, h, 4, TL + b * CTXL, 0, lamp, subg); }
}

__device__ __forceinline__ void conv_phase(const Ctx& C0, const float* cw, const float* cb) {
    const Ctx C = fresh(C0);
    const bf16_t* XR = (const bf16_t*)(C.ws + WS_XR); bf16_t* XC = (bf16_t*)(C.ws + WS_XC);
    const int gw = C.vcu * 8 + C.wave, NGW = C.G * 8;
    constexpr int NRB = T / 32;
    for (int item = gw; item < NRB * 5; item += NGW) {
        const int rb = item / 5, cg = item % 5, ch = cg * 512 + 8 * C.lane, r0 = rb * 32;
        const int seglen = r0 < TL ? SEQ : CTXL; const int sbase = r0 < TL ? (r0 & ~(SEQ - 1)) : TL + ((r0 - TL) & ~(CTXL - 1));
        const int s0 = r0 - sbase;
        float w[4][8], bias[8];
#pragma unroll
        for (int j = 0; j < 4; ++j) { const f32x4 a = *(const f32x4*)(cw + j * DR + ch), b = *(const f32x4*)(cw + j * DR + ch + 4);
#pragma unroll
            for (int k = 0; k < 4; ++k) { w[j][k] = a[k]; w[j][4 + k] = b[k]; } }
        { const f32x4 a = *(const f32x4*)(cb + ch), b = *(const f32x4*)(cb + ch + 4);
#pragma unroll
          for (int k = 0; k < 4; ++k) { bias[k] = a[k]; bias[4 + k] = b[k]; } }
        float win[4][8];
#define CV_LOAD(dst, s) do { const int s_ = (s); u32x4 x_ = (u32x4){0u, 0u, 0u, 0u}; if (s_ >= 0 && s_ < seglen) x_ = *(const u32x4*)(XR + (size_t)(sbase + s_) * DR + ch); \
        dst[0] = bf_lo(x_.x); dst[1] = bf_hi(x_.x); dst[2] = bf_lo(x_.y); dst[3] = bf_hi(x_.y); dst[4] = bf_lo(x_.z); dst[5] = bf_hi(x_.z); dst[6] = bf_lo(x_.w); dst[7] = bf_hi(x_.w); } while (0)
        CV_LOAD(win[0], s0 - 2); CV_LOAD(win[1], s0 - 1); CV_LOAD(win[2], s0);
        for (int i = 0; i < 32; ++i) {
            CV_LOAD(win[3], s0 + i + 1);
            float o[8];
#pragma unroll
            for (int k = 0; k < 8; ++k) o[k] = bias[k] + w[0][k] * win[0][k] + w[1][k] * win[1][k] + w[2][k] * win[2][k] + w[3][k] * win[3][k];
            u32x4 ow; ow.x = cvt_pk_bf16(o[0], o[1]); ow.y = cvt_pk_bf16(o[2], o[3]); ow.z = cvt_pk_bf16(o[4], o[5]); ow.w = cvt_pk_bf16(o[6], o[7]);
            *(u32x4*)(XC + (size_t)(r0 + i) * DR + ch) = ow;
#pragma unroll
            for (int k = 0; k < 8; ++k) { win[0][k] = win[1][k]; win[1][k] = win[2][k]; win[2][k] = win[3][k]; }
        }
#undef CV_LOAD
    }
}

__device__ __forceinline__ int chunk_row(int bb, int c) { return c < 4 ? 8192 + bb * 256 + 64 * c : bb * 4096 + 64 * (c - 4); }

__device__ __forceinline__ void scan_pass1(const Ctx& C0) {
    const Ctx C = fresh(C0);
    const unsigned short* AB = (const unsigned short*)(C.ws + WS_AB);
    f32x2* PH = (f32x2*)(C.ws + WS_PH);
    const int gw = C.vcu * 8 + C.wave, NGW = C.G * 8;
    for (int item = gw; item < 2 * 68 * 20; item += NGW) {
        const int bb = item / (68 * 20), rem = item % (68 * 20), c = rem / 20, ch = (rem % 20) * 128 + 2 * C.lane;
        const int r0 = chunk_row(bb, c);
#pragma unroll
        for (int dir = 0; dir < 2; ++dir) {
            const unsigned short* A1 = AB + (size_t)(2 * dir) * ((size_t)QROWS * DR) + ch;
            const unsigned short* Bq = AB + (size_t)(2 * dir + 1) * ((size_t)QROWS * DR) + ch;
            float P0 = 1.f, P1 = 1.f, H0 = 0.f, H1 = 0.f;
#pragma unroll 16
            for (int t = 0; t < 64; ++t) { const int r = r0 + (dir ? 63 - t : t);
                const unsigned aw = *(const unsigned*)(A1 + (size_t)r * DR), bw = *(const unsigned*)(Bq + (size_t)r * DR);
                const float a0 = 1.0f - h_lo(aw), a1 = 1.0f - h_hi(aw);
                H0 = a0 * H0 + h_lo(bw); H1 = a1 * H1 + h_hi(bw); P0 *= a0; P1 *= a1; }
            const size_t o = ((size_t)(bb * 2 + dir) * 68 + c) * DR + ch;
            PH[o] = (f32x2){P0, H0}; PH[o + 1] = (f32x2){P1, H1};
        }
    }
}
__device__ __forceinline__ void scan_pass2(const Ctx& C0) {
    const Ctx C = fresh(C0);
    const f32x2* PH = (const f32x2*)(C.ws + WS_PH); float* CR = (float*)(C.ws + WS_CARRY);
    const int gt = C.vcu * 512 + C.tid;
    if (gt < 2 * 2 * DR) {
        const int bd = gt / DR, ch = gt % DR, dir = bd & 1;
        const f32x2* ph = PH + (size_t)bd * 68 * DR + ch; float* cr = CR + (size_t)bd * 68 * DR + ch;
        float st = 0.f;
#pragma unroll 4
        for (int i = 0; i < 68; ++i) { const int c = dir ? (i < 4 ? 3 - i : 71 - i) : i;
            const f32x2 v = ph[(size_t)c * DR]; cr[(size_t)c * DR] = st; st = v.x * st + v.y; }
    }
}
__device__ __forceinline__ void scan_pass3(const Ctx& C0, int q) {
    const Ctx C = fresh(C0);
    const unsigned short* AB = (const unsigned short*)(C.ws + WS_AB);
    const float* CR = (const float*)(C.ws + WS_CARRY);
    bf16_t* GG = (bf16_t*)(C.ws + WS_GG);
    const int gw = C.vcu * 8 + C.wave, NGW = C.G * 8;
    const size_t ARR = (size_t)QROWS * DR;
    for (int item = gw; item < 2 * 64 * 20; item += NGW) {
        const int bb = item / (64 * 20), rem = item % (64 * 20), c = 4 + rem / 20, ch = (rem % 20) * 128 + 2 * C.lane;
        const int r0 = chunk_row(bb, c);
        const int grow0 = (2 * q + bb) * SEQ + 64 * (c - 4);
        float hf0[64], hf1[64];
        { const unsigned short* A1 = AB + ch; const unsigned short* Bq = AB + ARR + ch;
          const size_t co = ((size_t)(bb * 2 + 0) * 68 + c) * DR + ch;
          float s0 = CR[co], s1 = CR[co + 1];
#pragma unroll
          for (int t = 0; t < 64; ++t) { const unsigned aw = *(const unsigned*)(A1 + (size_t)(r0 + t) * DR), bw = *(const unsigned*)(Bq + (size_t)(r0 + t) * DR);
              s0 = (1.0f - h_lo(aw)) * s0 + h_lo(bw); s1 = (1.0f - h_hi(aw)) * s1 + h_hi(bw); hf0[t] = s0; hf1[t] = s1; } }
        { const unsigned short* A1 = AB + 2 * ARR + ch; const unsigned short* Bq = AB + 3 * ARR + ch;
          const size_t co = ((size_t)(bb * 2 + 1) * 68 + c) * DR + ch;
          float s0 = CR[co], s1 = CR[co + 1];
#pragma unroll
          for (int t = 63; t >= 0; --t) { const unsigned aw = *(const unsigned*)(A1 + (size_t)(r0 + t) * DR), bw = *(const unsigned*)(Bq + (size_t)(r0 + t) * DR);
              s0 = (1.0f - h_lo(aw)) * s0 + h_lo(bw); s1 = (1.0f - h_hi(aw)) * s1 + h_hi(bw);
              unsigned* gp = (unsigned*)(GG + (size_t)(grow0 + t) * DR + ch); const unsigned gw2 = *gp;
              *gp = cvt_pk_bf16((hf0[t] + s0) * bf_lo(gw2), (hf1[t] + s1) * bf_hi(gw2)); } }
    }
}


#define GRID_BAR() xcd_barrier(bar)
template <int LAYER, int F>
__device__ __forceinline__ void ffn_sub(const Ctx& C, const Params& P, const XcdBarrier& bar) {
    using namespace pg8;
    const float* MOD = (const float*)(C.ws + WS_MOD);
    float* X = (float*)(C.ws + WS_X);
    const int cid = (int)blockIdx.x;
    const float* modl = MOD + (size_t)LAYER * 9 * NMOD;
    constexpr int sub = F * 2, lf = LAYER * 2 + F;
    constexpr int Mf = (LAYER == 1 && F == 1) ? TL : T;
    { Gemm g{(const bf16_t*)(C.ws + WS_U), (const bf16_t*)(C.ws + WS_WGU) + (size_t)lf * 11264 * WP2, D, 64, D, (size_t)128, (size_t)32768}; StdOrder S; S.init(Mf, 2 * FF, D, D, D, C.G, cid);
      EpiSwiGLU E{(bf16_t*)(C.ws + WS_H)};
#ifndef NO_GU
      gemm_phase<EpiSwiGLU, StdOrder, true>(C.lds, g, S, E);
#endif
    }
    if constexpr (lf == 0) {
        const int nun = (Mf / 256) * 44, rem = nun % C.G;
        if (rem == 0) prologue_mod(C, P, 1, cid, C.G); else if (cid >= rem) prologue_mod(C, P, 1, cid - rem, C.G - rem);
    }
    GRID_BAR();
    { Gemm g{(const bf16_t*)(C.ws + WS_H), (const bf16_t*)(C.ws + WS_WD) + (size_t)lf * D * WP5, 64, 64, FF, (size_t)32768, (size_t)32768};
      constexpr bool first = (LAYER == 0 && F == 0);
      constexpr int pls = first ? 0 : LAYER * 3 + sub - 1;
      EpiResid<!first> E{first ? PIN(0) : X, first ? PIN(2) : X + (size_t)TL * D, X, modl + (size_t)sub * 3 * D + 2 * D, 0.5f,
                 (const float*)(C.ws + WS_STATS), PIN(6) + (size_t)pls * D, PIN(7) + (size_t)pls * D, (float*)(C.ws + WS_PART)};
#ifndef NO_DOWN
      if constexpr (Mf == T) { SplitOrder S; S.init(64 * HKT, 64 * HKT, FF, C.G, cid); S.kqA = (size_t)(HKT / 4) * 32768; S.kqB = S.kqA; gemm_phase<EpiResid<!first>, SplitOrder, true>(C.lds, g, S, E); }
      else { StdOrder S; S.init(Mf, D, 64 * HKT, 64 * HKT, FF, C.G, cid); gemm_phase<EpiResid<!first>, StdOrder, true>(C.lds, g, S, E); }
#endif
    }
    if constexpr (lf < 3) {
        convert_in_tail(C, P, 0, wc::GU0 + (lf + 1) * 2 * wc::I_G, wc::GU0 + (lf + 2) * 2 * wc::I_G);
        convert_in_tail(C, P, 0, wc::WD0 + (lf + 1) * wc::I_D, wc::WD0 + (lf + 2) * wc::I_D);
    }
    GRID_BAR();
    if constexpr (LAYER == 1 && F == 1) {
        ln_phase(C, TL, PIN(6) + (size_t)(LAYER * 3 + sub) * D, PIN(7) + (size_t)(LAYER * 3 + sub) * D, nullptr, nullptr, POUT(), CtxComb{nullptr, nullptr, nullptr, nullptr, nullptr, 0.f, false});
    } else {
        const float* modn = (F == 0) ? modl + 1 * 3 * D : MOD + (size_t)(LAYER + 1) * 9 * NMOD;
        bf16_t* Un = (F == 0 && LAYER == 1) ? (bf16_t*)(C.ws + WS_ULRU) : (bf16_t*)(C.ws + WS_U);
        constexpr bool first = (LAYER == 0 && F == 0);
        constexpr int pls = first ? 0 : LAYER * 3 + sub - 1;
        ln_phase(C, T, PIN(6) + (size_t)(LAYER * 3 + sub) * D, PIN(7) + (size_t)(LAYER * 3 + sub) * D, modn, Un, nullptr,
                 CtxComb{(const float*)(C.ws + WS_PART), first ? PIN(2) : nullptr, PIN(6) + (size_t)pls * D, PIN(7) + (size_t)pls * D, modl + (size_t)sub * 3 * D + 2 * D + (size_t)8 * NMOD, 0.5f, true});
        GRID_BAR();
    }
}

__device__ __forceinline__ void attn_mixer(const Ctx& C, const Params& P, const XcdBarrier& bar) {
    using namespace pg8;
    const float* modl = (const float*)(C.ws + WS_MOD);
    float* X = (float*)(C.ws + WS_X);
    const int cid = (int)blockIdx.x;
    { Gemm g{(const bf16_t*)(C.ws + WS_U), (const bf16_t*)(C.ws + WS_WQK), D, WP2, D}; StdOrder S; S.init(T, 2 * D, D, WP2, D, C.G, cid);
      EpiQK E{(bf16_t*)(C.ws + WS_Q), (bf16_t*)(C.ws + WS_K), (const float*)(C.ws + WS_TAB)};
#ifndef NO_QK
      gemm_phase<EpiQK, StdOrder, true>(C.lds, g, S, E);
#endif
    }
    { Gemm g{(const bf16_t*)(C.ws + WS_WV), (const bf16_t*)(C.ws + WS_U), WP2, D, D}; StdOrder S; S.init(D, T, WP2, D, D, C.G, C.G - 1 - cid);
      EpiBf16 E{(bf16_t*)(C.ws + WS_VT), T};
#ifndef NO_VT
      gemm_phase<EpiBf16, StdOrder, true>(C.lds, g, S, E);
#endif
    }
    GRID_BAR();
#ifndef NO_ATT
    attn_phase(C, PIN(17));
#endif
    GRID_BAR();
    { Gemm g{(const bf16_t*)(C.ws + WS_O), (const bf16_t*)(C.ws + WS_WO), D, WP2, D}; SplitOrder S; S.init(D, WP2, D, C.G, cid);
      EpiResid<true> E{X, X + (size_t)TL * D, X, modl + 1 * 3 * D + 2 * D, 1.0f, (const float*)(C.ws + WS_STATS), PIN(6), PIN(7), (float*)(C.ws + WS_PART)};
#ifndef NO_WO
      gemm_phase<EpiResid<true>, SplitOrder, true>(C.lds, g, S, E);
#endif
    }
    convert_in_tail(C, P, 0, wc::LRU0, wc::NITEMS);
    GRID_BAR();
    ln_phase(C, T, PIN(6) + (size_t)1 * D, PIN(7) + (size_t)1 * D, modl + 2 * 3 * D, (bf16_t*)(C.ws + WS_U), nullptr,
             CtxComb{(const float*)(C.ws + WS_PART), nullptr, PIN(6), PIN(7), modl + 1 * 3 * D + 2 * D + (size_t)8 * NMOD, 1.0f, true});
    GRID_BAR();
}

__device__ __forceinline__ void lru_mixer(const Ctx& C, const Params& P, const XcdBarrier& bar) {
    using namespace pg8;
    const float* modl = (const float*)(C.ws + WS_MOD) + (size_t)9 * NMOD;
    float* X = (float*)(C.ws + WS_X);
    const int cid = (int)blockIdx.x;
    { Gemm g{(const bf16_t*)(C.ws + WS_ULRU), (const bf16_t*)(C.ws + WS_WIN), D, WP2, D}; StdOrder S; S.init(T, 2 * DR, D, WP2, D, C.G, cid);
      EpiWin E{(bf16_t*)(C.ws + WS_GG), (bf16_t*)(C.ws + WS_XR)};
#ifndef NO_WIN
      gemm_phase<EpiWin, StdOrder, true>(C.lds, g, S, E);
#endif
    }
    GRID_BAR();
#ifndef NO_CONV
    conv_phase(C, PIN(19), PIN(20));
#endif
    GRID_BAR();
#pragma unroll 1
    for (int q = 0; q < 4; ++q) {
        { Gemm g{(const bf16_t*)(C.ws + WS_XC), (const bf16_t*)(C.ws + WS_WAI), DR, 256, 256}; GateOrder S{C.G, cid, q};
          EpiGates E{(const bf16_t*)(C.ws + WS_XC), PIN(22), PIN(24), (const float*)(C.ws + WS_C8), (unsigned short*)(C.ws + WS_AB), q};
#ifndef NO_GATES
          gemm_phase<EpiGates, GateOrder, true>(C.lds, g, S, E);
#endif
        }
        GRID_BAR();
#ifndef NO_SCAN
        scan_pass1(C);
#endif
        GRID_BAR();
#ifndef NO_SCAN
        scan_pass2(C);
#endif
        GRID_BAR();
#ifndef NO_SCAN3
        scan_pass3(C, q);
#endif
        GRID_BAR();
    }
    { Gemm g{(const bf16_t*)(C.ws + WS_GG), (const bf16_t*)(C.ws + WS_WOUT), DR, WPR, DR}; StdOrder S; S.init(TL, D, DR, WPR, DR, C.G, cid);
      EpiResid<true> E{X, X + (size_t)TL * D, X, modl + 1 * 3 * D + 2 * D, 1.0f, (const float*)(C.ws + WS_STATS), PIN(6) + (size_t)3 * D, PIN(7) + (size_t)3 * D, nullptr};
#ifndef NO_WOUT
      gemm_phase<EpiResid<true>, StdOrder, true>(C.lds, g, S, E);
#endif
    }
    GRID_BAR();
    ln_phase(C, TL, PIN(6) + (size_t)4 * D, PIN(7) + (size_t)4 * D, modl + 2 * 3 * D, (bf16_t*)(C.ws + WS_U), nullptr, CtxComb{nullptr, nullptr, nullptr, nullptr, nullptr, 0.f, false});
    GRID_BAR();
}

__global__ void __launch_bounds__(512, 2) fwd_kernel(Params P) {
    extern __shared__ __attribute__((aligned(16))) unsigned char lds_raw[];
    Ctx C;
    C.lds = (LAS unsigned char*)lds_raw; C.ws = P.ws;
    C.tid = threadIdx.x; C.lane = C.tid & 63; C.wave = __builtin_amdgcn_readfirstlane(C.tid >> 6);
    C.G = gridDim.x; { const int bx = blockIdx.x; C.vcu = (C.G % 8 == 0) ? (bx % 8) * (C.G / 8) + bx / 8 : bx; }
    volatile LAS unsigned* MISC = (volatile LAS unsigned*)(C.lds + MISC_OFF);
    if (C.tid < 32) MISC[C.tid] = 0u;
    __syncthreads();
    XcdBarrier bar = xcd_barrier_post((unsigned*)(C.ws + WS_CTL) + CW_BAR, MISC + 8);

#ifndef NO_PRO
    prologue_mod(C, P, 0, C.vcu, C.G);
    prologue_small(C, P);
    { const int w = C.vcu * 8 + C.wave, n = C.G * 8;
      convert_weights(C, P, wc::GU0, wc::GU0 + 2 * wc::I_G, w, n); convert_weights(C, P, wc::WD0, wc::WD0 + wc::I_D, w, n); convert_weights(C, P, wc::ATT0, wc::LRU0, w, n); }
#endif
    GRID_BAR();
    prep_phase(C, P);
    GRID_BAR();


    ffn_sub<0, 0>(C, P, bar);
    attn_mixer(C, P, bar);
    ffn_sub<0, 1>(C, P, bar);
    ffn_sub<1, 0>(C, P, bar);
    lru_mixer(C, P, bar);
    ffn_sub<1, 1>(C, P, bar);
}

extern "C" void kernel_launch(void* const* d_in, const int* in_sizes, int n_in, void* d_out, int out_size, void* d_ws, size_t ws_size, hipStream_t stream) {
    static int grid = 0;
    if (grid == 0) {
        if (n_in != 27 || ws_size < WS_END) { fprintf(stderr, "kernel_launch: unexpected n_in %d / ws_size %zu (need %zu)\n", n_in, ws_size, (size_t)WS_END); grid = -1; return; }
        int dev = 0, cus = 0, per_cu = 0;
        if (hipGetDevice(&dev) != hipSuccess || hipDeviceGetAttribute(&cus, hipDeviceAttributeMultiprocessorCount, dev) != hipSuccess) { grid = -1; return; }
        if (hipFuncSetAttribute((const void*)fwd_kernel, hipFuncAttributeMaxDynamicSharedMemorySize, LDS_BYTES) != hipSuccess) { fprintf(stderr, "kernel_launch: hipFuncSetAttribute failed\n"); grid = -1; return; }
        if (hipOccupancyMaxActiveBlocksPerMultiprocessor(&per_cu, (const void*)fwd_kernel, 512, LDS_BYTES) != hipSuccess || per_cu < 1) fprintf(stderr, "kernel_launch: occupancy query says %d\n", per_cu);
        (void)hipGetLastError();
        grid = cus;
    }
    if (grid < 0) return;
    (void)hipMemsetAsync((char*)d_ws + WS_CTL, 0, CTL_ZERO_BYTES, stream);
    Params p{};
    for (int i = 0; i < 27; ++i) p.in[i] = (const float*)d_in[i];
    p.out = (float*)d_out; p.ws = (unsigned char*)d_ws;
    hipLaunchKernelGGL(fwd_kernel, dim3(grid), dim3(512), LDS_BYTES, stream, p);
}
```

```cpp
#include <hip/hip_runtime.h>
#include <cstdio>
#include <cstdint>

#define LAS __attribute__((address_space(3)))
#define GAS __attribute__((address_space(1)))
typedef unsigned short bf16_t;
typedef short bf16x8 __attribute__((ext_vector_type(8)));
typedef float f32x4 __attribute__((ext_vector_type(4)));
typedef float f32x2 __attribute__((ext_vector_type(2)));
typedef float f32x16 __attribute__((ext_vector_type(16)));
typedef unsigned u32x4 __attribute__((ext_vector_type(4)));
typedef unsigned u32x2 __attribute__((ext_vector_type(2)));
typedef GAS unsigned gu32;

constexpr int D = 2048, NB = 8, SEQ = 4096, CTXL = 256;
constexpr int TL = NB * SEQ;
constexpr int TC = NB * CTXL;
constexpr int T = TL + TC;
constexpr int HKT = 5632 / 64;
constexpr int WP2 = 2048 + 64, WP5 = 5632 + 128, WPR = 2560 + 64;
constexpr int FF = 5632, DR = 2560, NMOD = 9 * D;
constexpr float ALPHA = 1.4142135623730951f;
constexpr float LN_EPS = 1e-6f;
constexpr float LOG2E = 1.4426950408889634f;
constexpr float QSCALE = 0.125f * LOG2E;
constexpr int QROWS = 34 * 256;

constexpr size_t MiB = 1u << 20;
constexpr size_t WS_CTL = 0, CTL_ZERO_BYTES = 1 * MiB;
constexpr size_t WS_MOD = 1 * MiB;
constexpr size_t WS_TAB = 3 * MiB;
constexpr size_t WS_LAM = 3 * MiB + 16384;
constexpr size_t WS_C8 = 3 * MiB + 32768;
constexpr size_t WS_STATS = 3 * MiB + 131072;
constexpr size_t WS_WGU = 4 * MiB;
constexpr size_t SZ_WGU = (size_t)11264 * WP2 * 2, SZ_WD = (size_t)2048 * WP5 * 2;
constexpr size_t WS_WD = 186 * MiB;
constexpr size_t WS_WQK = 276 * MiB, WS_WV = 293 * MiB, WS_WO = 302 * MiB;
constexpr size_t WS_WIN = 311 * MiB, WS_WAI = 332 * MiB, WS_WOUT = 337 * MiB;
static_assert(WS_WGU + 4 * SZ_WGU <= WS_WD && WS_WD + 4 * SZ_WD <= WS_WQK && WS_WQK + (size_t)4096 * WP2 * 2 <= WS_WV && WS_WV + (size_t)2048 * WP2 * 2 <= WS_WO && WS_WO + (size_t)2048 * WP2 * 2 <= WS_WIN
              && WS_WIN + (size_t)5120 * WP2 * 2 <= WS_WAI && WS_WAI + (size_t)10240 * 256 * 2 <= WS_WOUT && WS_WOUT + (size_t)2048 * WPR * 2 <= 348 * MiB, "weight map");
constexpr size_t WS_X = 348 * MiB;
constexpr size_t WS_U = 620 * MiB;
constexpr size_t WS_H = 756 * MiB;
constexpr size_t WS_Q = 756 * MiB, WS_K = 892 * MiB, WS_VT = 1028 * MiB, WS_O = 620 * MiB;
constexpr size_t WS_GG = 620 * MiB, WS_XR = 790 * MiB, WS_XC = 960 * MiB, WS_ULRU = 960 * MiB, WS_AB = 790 * MiB;
constexpr size_t AB_ARR = (size_t)QROWS * DR * 2;
constexpr size_t WS_PH = 1130 * MiB;
constexpr size_t WS_CARRY = 1138 * MiB;
constexpr size_t WS_PART = 1146 * MiB;
constexpr size_t WS_END = 1210 * MiB;
static_assert(WS_H + (size_t)T * FF * 2 <= WS_PART && WS_XC + (size_t)T * DR * 2 <= WS_PH, "activation map");
static_assert(WS_AB + 4 * AB_ARR <= WS_XC, "AB fits in XR's region");

constexpr int CW_BAR = 4096;
constexpr int LDS_BYTES = 147456;
constexpr int MISC_OFF = 131072 + 320;

typedef __bf16 bf16x2_t __attribute__((ext_vector_type(2)));
__device__ __forceinline__ unsigned cvt_pk_bf16(float lo, float hi) { f32x2 v = {lo, hi}; bf16x2_t b = __builtin_convertvector(v, bf16x2_t); return __builtin_bit_cast(unsigned, b); }
__device__ __forceinline__ unsigned f2bf(float f) { unsigned u = __builtin_bit_cast(unsigned, f); return (u + 0x7fffu + ((u >> 16) & 1u)) >> 16; }
__device__ __forceinline__ unsigned pk2(float lo, float hi) { return f2bf(lo) | (f2bf(hi) << 16); }
__device__ __forceinline__ float bf_lo(unsigned w) { return __uint_as_float(w << 16); }
__device__ __forceinline__ float bf_hi(unsigned w) { return __uint_as_float(w & 0xffff0000u); }
typedef _Float16 h2_t __attribute__((ext_vector_type(2)));
__device__ __forceinline__ unsigned pk_f16(float a, float b) { h2_t v = {(_Float16)a, (_Float16)b}; return __builtin_bit_cast(unsigned, v); }
__device__ __forceinline__ float h_lo(unsigned w) { h2_t v = __builtin_bit_cast(h2_t, w); return (float)v.x; }
__device__ __forceinline__ float h_hi(unsigned w) { h2_t v = __builtin_bit_cast(h2_t, w); return (float)v.y; }
__device__ __forceinline__ float fast_sigmoid(float x) { return __builtin_amdgcn_rcpf(1.0f + __builtin_amdgcn_exp2f(-LOG2E * x)); }
__device__ __forceinline__ int lane_id() { unsigned m = ~0u; asm volatile("" : "+s"(m)); int l = (int)__builtin_amdgcn_mbcnt_hi(m, __builtin_amdgcn_mbcnt_lo(m, 0u)); asm volatile("" : "+v"(l)); return l; }
__device__ __forceinline__ float wave_sum(float v) {
#pragma unroll
    for (int o = 1; o < 64; o <<= 1) v += __shfl_xor(v, o);
    return v;
}
__device__ __forceinline__ float swap32(float v) { return __shfl_xor(v, 32); }

#define XB_TMO      128
#define XB_XCNT(j)  (256  + 64 * (j))
#define XB_XSUB(j)  (1280 + 64 * (j))
#define XB_XGEN(j)  (2304 + 64 * (j))
#define XB_TOP      3328
#define XB_TOPGEN   3392
#define XCD_BAR_WORDS 3456
#define XB_SPIN_CAP (1u << 22)
__device__ __forceinline__ unsigned xb_ld(unsigned* p)              { return __hip_atomic_load(p, __ATOMIC_RELAXED, __HIP_MEMORY_SCOPE_AGENT); }
__device__ __forceinline__ unsigned xb_add(unsigned* p, unsigned v) { return __hip_atomic_fetch_add(p, v, __ATOMIC_RELAXED, __HIP_MEMORY_SCOPE_AGENT); }
__device__ __forceinline__ unsigned xb_xcc_id() { return (unsigned)__builtin_amdgcn_s_getreg((3 << 11) | 20) & 0xFu; }
#define XB_SPIN(cond, bar) do { unsigned _sp = 0; while (cond) { __builtin_amdgcn_s_sleep(1); \
    if ((++_sp & 255u) == 0u) { if (xb_ld(&(bar)[XB_TMO])) break; if (_sp > XB_SPIN_CAP) { atomicAdd(&(bar)[XB_TMO], 1u); break; } } } } while (0)
struct XcdBarrier { unsigned* bar; unsigned x; volatile LAS unsigned* st; int wave; };
__device__ __forceinline__ XcdBarrier xcd_barrier_post(unsigned* bar, volatile LAS unsigned* st) {
    XcdBarrier b; b.bar = bar; b.x = xb_xcc_id(); b.st = st; b.wave = __builtin_amdgcn_readfirstlane((int)(threadIdx.x >> 6));
    if (threadIdx.x == 0) (void)xb_add(&bar[XB_XCNT(b.x)], 1u);
    return b;
}
__device__ __forceinline__ void xcd_barrier_complete(unsigned* bar, unsigned x, unsigned& nloc, unsigned& nx) {
    const unsigned G = gridDim.x * gridDim.y * gridDim.z;
    unsigned sum, cnt, mine, sp = 0u;
    for (;;) {
        sum = 0u; cnt = 0u; mine = 0u;
#pragma unroll
        for (unsigned j = 0; j < 16; ++j) { const unsigned c = xb_ld(&bar[XB_XCNT(j)]); sum += c; cnt += (c > 0u) ? 1u : 0u; mine = (j == x) ? c : mine; }
        if (sum == G) break;
        __builtin_amdgcn_s_sleep(1);
        if ((++sp & 255u) == 0u) { if (xb_ld(&bar[XB_TMO])) break; if (sp > XB_SPIN_CAP) { atomicAdd(&bar[XB_TMO], 1u); break; } }
    }
    nloc = mine > 0u ? mine : 1u; nx = cnt > 0u ? cnt : 1u;
}
__device__ __forceinline__ void xcd_barrier(const XcdBarrier& b) {
    asm volatile("s_waitcnt vmcnt(0)" ::: "memory");
    __syncthreads();
    if (b.wave == 0 && lane_id() == 0) {
        unsigned* bar = b.bar;
        __builtin_amdgcn_s_waitcnt(0);
        unsigned nloc = b.st[0], nx = b.st[1];
        if (nloc == 0u) { xcd_barrier_complete(bar, b.x, nloc, nx); b.st[0] = nloc; b.st[1] = nx; }
        const unsigned old = xb_add(&bar[XB_XSUB(b.x)], 1u);
        const unsigned gen = old / nloc;
        if (old + 1u == (gen + 1u) * nloc) {
            __builtin_amdgcn_fence(__ATOMIC_RELEASE, "agent");
            asm volatile("s_waitcnt vmcnt(0)" ::: "memory");
            const unsigned og = xb_add(&bar[XB_TOP], 1u);
            const unsigned tg = og / nx;
            if (og + 1u == (tg + 1u) * nx) xb_add(&bar[XB_TOPGEN], 1u);
            else XB_SPIN(xb_ld(&bar[XB_TOPGEN]) == tg, bar);
            __builtin_amdgcn_fence(__ATOMIC_ACQUIRE, "agent");
            xb_add(&bar[XB_XGEN(b.x)], 1u);
            asm volatile("s_waitcnt vmcnt(0)" ::: "memory");
        } else {
            XB_SPIN(xb_ld(&bar[XB_XGEN(b.x)]) == gen, bar);
            __builtin_amdgcn_fence(__ATOMIC_ACQUIRE, "agent");
            asm volatile("s_waitcnt vmcnt(0)" ::: "memory");
        }
    }
    __syncthreads();
}

namespace pg8 {
constexpr int BM = 256, BK = 64, HALF = 128, HTB = HALF * BK * 2, STAGE_BYTES = 8 * HTB, NXCD = 8, WGM = 4;
__host__ __device__ __forceinline__ int lds_byte(int r, int c) { const int st = (r >> 4) * 2 + (c >> 5), rr = r & 15, cc = c & 31, ob = rr * 64 + cc * 2; return st * 1024 + (ob ^ (((ob >> 9) & 1) << 5)); }
__host__ __device__ __forceinline__ void stage_rc(int b, int& R, int& C) { const int st = b / 1024, sb = b % 1024, swz = sb ^ (((sb >> 9) & 1) << 5); R = (st >> 1) * 16 + swz / 64; C = (st & 1) * 32 + (swz % 64) / 2; }
__host__ __device__ __forceinline__ int perm32(int rho) { const int n = rho >> 4, i = rho & 15; return 8 * (i >> 2) + 4 * n + (i & 3); }

struct Unit { int pm, pn; size_t aoff, boff; int kt, part; };
struct Gemm { const bf16_t* A; const bf16_t* Bt; int lda, ldb, K; size_t kstepA = 128, kstepB = 128; };

__device__ __forceinline__ bool order_next(int nM, int nN, int G, int c, int i, int& pm, int& pn) {
    const int nwg = nM * nN; const long L = (long)i * G + c; if (L >= nwg) return false;
    int wgid = (int)L; { const int q = nwg / NXCD, r = nwg % NXCD, xcd = wgid % NXCD, off = wgid / NXCD; wgid = (xcd < r ? xcd * (q + 1) : r * (q + 1) + (xcd - r) * q) + off; }
    const int nig = WGM * nN, gid = wgid / nig, fm = gid * WGM, gsz = (nM - fm) < WGM ? (nM - fm) : WGM;
    pm = fm + ((wgid % nig) % gsz); pn = (wgid % nig) / gsz; return true;
}
struct StdOrder {
    int nM, nN, G, c, kt; size_t astep, bstep;
    __device__ __forceinline__ void init(int M, int N, int lda, int ldb, int K, int G_, int c_) { nM = M / BM; nN = N / BM; G = G_; c = c_; kt = K / BK; astep = (size_t)BM * lda * 2; bstep = (size_t)BM * ldb * 2; }
    __device__ __forceinline__ bool next(int i, Unit& u) const { if (!order_next(nM, nN, G, c, i, u.pm, u.pn)) return false; u.aoff = (size_t)u.pm * astep; u.boff = (size_t)u.pn * bstep; u.kt = kt; u.part = -1; return true; }
};
struct SplitOrder {
    int G, c, K; size_t astep, bstep, kqA, kqB;
    __device__ __forceinline__ void init(int lda, int ldb, int K_, int G_, int c_) { G = G_; c = c_; K = K_; astep = (size_t)BM * lda * 2; bstep = (size_t)BM * ldb * 2; kqA = (size_t)(K_ / 4) * 2; kqB = kqA; }
    __device__ __forceinline__ bool next(int i, Unit& u) const {
        if (order_next(128, 8, G, c, i, u.pm, u.pn)) { u.aoff = (size_t)u.pm * astep; u.boff = (size_t)u.pn * bstep; u.kt = K / BK; u.part = -1; return true; }
        const long s = (long)i * G + c - 1024; if (s < 0 || s >= 256) return false;
        const int cu = (int)s >> 2, ks = (int)s & 3, kq = K / 4;
        u.pm = 128 + (cu >> 3); u.pn = cu & 7; u.aoff = (size_t)u.pm * astep + (size_t)ks * kqA; u.boff = (size_t)u.pn * bstep + (size_t)ks * kqB; u.kt = kq / BK; u.part = ks; return true;
    }
};
struct GateOrder {
    int G, c, q;
    __device__ __forceinline__ bool next(int i, Unit& u) const {
        if (!order_next(34, 40, G, c, i, u.pm, u.pn)) return false;
        const int gp = u.pm < 32 ? 32 * q + u.pm : 128 + 2 * q + (u.pm - 32);
        const int blk = (u.pn % 20) >> 1;
        u.aoff = ((size_t)gp * BM * DR + (size_t)blk * 256) * 2; u.boff = (size_t)u.pn * BM * 256 * 2; u.kt = 4; u.part = -1; return true;
    }
};

template <class Epi, class Sched, bool ALIGN_EPI>
__device__ __forceinline__ void gemm_phase(LAS unsigned char* lds, const Gemm g, const Sched& S, const Epi& E, const int wid0) {
    int lane = lane_id(); int wid = wid0; asm volatile("" : "+v"(lane), "+s"(wid));
    const int tid = wid * 64 + lane, wr = wid >> 2, wc = wid & 3, fr = lane & 15, fq = lane >> 4;
    unsigned voffA[2], voffB[2];
#pragma unroll
    for (int i = 0; i < 2; ++i) { int R, C; stage_rc(tid * 16 + i * 8192, R, C); const int Rb = Epi::PERM ? ((R & ~31) + perm32(R & 31)) : R;
        voffA[i] = (unsigned)(R * g.lda + C) * 2u; voffB[i] = (unsigned)(Rb * g.ldb + C) * 2u; }
    const size_t kstep = g.kstepB, kstepA = g.kstepA;
    const size_t hstepA = (size_t)HALF * g.lda * 2, hstepB = (size_t)HALF * g.ldb * 2;
    const unsigned ldsw = (unsigned)wid * 1024u;
    const int aoff = lds_byte(wr * 64 + fr, fq * 8), boff = lds_byte(wc * 32 + fr, fq * 8);
#define PG8_SA(b, h) (((b) * 2 + (h)) * HTB)
#define PG8_SB(b, h) ((4 + (b) * 2 + (h)) * HTB)
#define PG8_STAGE(bufoff, gbase, voff) do { _Pragma("unroll") for (int _i = 0; _i < 2; ++_i) \
        __builtin_amdgcn_global_load_lds((const unsigned*)((const char*)(gbase) + (voff)[_i]), (LAS unsigned*)(lds + (bufoff) + ldsw + _i * 8192), 16, 0, 0); } while (0)
#define PG8_LDA(dst, b, h) do { _Pragma("unroll") for (int m = 0; m < 4; ++m) _Pragma("unroll") for (int k = 0; k < 2; ++k) dst[m][k] = *(const LAS bf16x8*)(lds + PG8_SA(b, h) + aoff + m * 2048 + k * 1024); } while (0)
#define PG8_LDB(dst, b, h) do { _Pragma("unroll") for (int n = 0; n < 2; ++n) _Pragma("unroll") for (int k = 0; k < 2; ++k) dst[n][k] = *(const LAS bf16x8*)(lds + PG8_SB(b, h) + boff + n * 2048 + k * 1024); } while (0)
#define PG8_MMA(ai, bj, At, Bt) do { __builtin_amdgcn_s_setprio(1); _Pragma("unroll") for (int m = 0; m < 4; ++m) _Pragma("unroll") for (int n = 0; n < 2; ++n) _Pragma("unroll") for (int k = 0; k < 2; ++k) \
        acc[ai][bj][m][n] = __builtin_amdgcn_mfma_f32_16x16x32_bf16(Bt[n][k], At[m][k], acc[ai][bj][m][n], 0, 0, 0); __builtin_amdgcn_s_setprio(0); } while (0)
#define PG8_WAIT_V(n) asm volatile("s_waitcnt vmcnt(" #n ")" ::: "memory")
#define PG8_WAIT_L(n) asm volatile("s_waitcnt lgkmcnt(" #n ")" ::: "memory")
#define PG8_BAR __builtin_amdgcn_s_barrier()
#define PG8_SCHED __builtin_amdgcn_sched_barrier(0)
    Unit cur, nxt; int ui = 0;
    if (!S.next(0, cur)) return;
    f32x4 acc[2][2][4][2];
#pragma unroll
    for (int a = 0; a < 2; ++a)
#pragma unroll
        for (int b = 0; b < 2; ++b)
#pragma unroll
            for (int m = 0; m < 4; ++m)
#pragma unroll
                for (int n = 0; n < 2; ++n) acc[a][b][m][n] = (f32x4){0.f, 0.f, 0.f, 0.f};
    bf16x8 At[4][2], B0[2][2], B1[2][2];
    const char* cA = (const char*)g.A + cur.aoff; const char* cB = (const char*)g.Bt + cur.boff;
    PG8_STAGE(PG8_SB(0, 0), cB, voffB); PG8_STAGE(PG8_SB(0, 1), cB + hstepB, voffB); PG8_STAGE(PG8_SA(0, 0), cA, voffA); PG8_STAGE(PG8_SA(0, 1), cA + hstepA, voffA);
    if (wr == 1) PG8_BAR;
    PG8_WAIT_V(2); PG8_BAR;
    PG8_STAGE(PG8_SB(1, 0), cB + kstep, voffB); PG8_STAGE(PG8_SA(1, 0), cA + kstepA, voffA); PG8_STAGE(PG8_SB(1, 1), cB + hstepB + kstep, voffB);
    PG8_WAIT_V(6); PG8_BAR;
    for (;;) {
        const bool has_next = S.next(ui + 1, nxt);
        const char* nA = has_next ? (const char*)g.A + nxt.aoff : cA; const char* nB = has_next ? (const char*)g.Bt + nxt.boff : cB;
        const int nt = cur.kt;
#pragma unroll 1
        for (int t = 0; t < nt; t += 2) {
            const bool last = (t == nt - 2);
            const char* a1 = cA + (size_t)(t + 1) * kstepA;
            const char* a2 = last ? nA : cA + (size_t)(t + 2) * kstepA; const char* b2 = last ? nB : cB + (size_t)(t + 2) * kstep;
            const char* a3 = a2 + kstepA; const char* b3 = b2 + kstep;
            PG8_LDB(B0, 0, 0); PG8_LDB(B1, 0, 1); PG8_SCHED; PG8_LDA(At, 0, 0); PG8_STAGE(PG8_SA(1, 1), a1 + hstepA, voffA);
            PG8_WAIT_V(8); PG8_WAIT_L(0); PG8_BAR; PG8_MMA(0, 0, At, B0); PG8_MMA(0, 1, At, B1); PG8_BAR; PG8_SCHED;
            PG8_LDA(At, 0, 1); PG8_STAGE(PG8_SB(0, 0), b2, voffB); PG8_STAGE(PG8_SB(0, 1), b2 + hstepB, voffB); PG8_STAGE(PG8_SA(0, 0), a2, voffA);
            PG8_WAIT_V(8); PG8_WAIT_L(0); PG8_BAR; PG8_MMA(1, 0, At, B0); PG8_MMA(1, 1, At, B1); PG8_BAR; PG8_SCHED;
            PG8_LDB(B0, 1, 0); PG8_LDB(B1, 1, 1); PG8_SCHED; PG8_LDA(At, 1, 0); PG8_STAGE(PG8_SA(0, 1), a2 + hstepA, voffA);
            PG8_WAIT_V(8); PG8_WAIT_L(0); PG8_BAR; PG8_MMA(0, 0, At, B0); PG8_MMA(0, 1, At, B1); PG8_BAR; PG8_SCHED;
            PG8_LDA(At, 1, 1); PG8_STAGE(PG8_SB(1, 0), b3, voffB); PG8_STAGE(PG8_SB(1, 1), b3 + hstepB, voffB); PG8_STAGE(PG8_SA(1, 0), a3, voffA);
            PG8_WAIT_V(8); PG8_WAIT_L(0); PG8_BAR; PG8_MMA(1, 0, At, B0); PG8_MMA(1, 1, At, B1); PG8_BAR; PG8_SCHED;
        }
        if constexpr (ALIGN_EPI) { if (wr == 0) PG8_BAR; }
        E(acc, cur, wr, wc, fr, fq);
        if (!has_next) break;
#pragma unroll
        for (int a = 0; a < 2; ++a)
#pragma unroll
            for (int b = 0; b < 2; ++b)
#pragma unroll
                for (int m = 0; m < 4; ++m)
#pragma unroll
                    for (int n = 0; n < 2; ++n) acc[a][b][m][n] = (f32x4){0.f, 0.f, 0.f, 0.f};
        cur = nxt; cA = nA; cB = nB; ++ui;
        if constexpr (ALIGN_EPI) { if (wr == 1) PG8_BAR; }
    }
    PG8_WAIT_V(0);
    if constexpr (!ALIGN_EPI) { if (wr == 0) PG8_BAR; }
    PG8_BAR;
#undef PG8_SA
#undef PG8_SB
#undef PG8_STAGE
#undef PG8_LDA
#undef PG8_LDB
#undef PG8_MMA
#undef PG8_WAIT_V
#undef PG8_WAIT_L
#undef PG8_BAR
#undef PG8_SCHED
}

typedef f32x4 Acc[2][2][4][2];

struct EpiSwiGLU {
    static constexpr bool PERM = true;
    bf16_t* H;
    __device__ __forceinline__ void operator()(const Acc& acc, const Unit& u, int wr, int wc, int fr, int fq) const {
        bf16_t* hp = H + (((size_t)u.pm * HKT + 2 * u.pn + (wc >> 1)) * 256 + wr * 64 + fr) * 64 + (wc & 1) * 32 + 8 * fq;
#pragma unroll
        for (int ai = 0; ai < 2; ++ai)
#pragma unroll
            for (int m = 0; m < 4; ++m) {
                const f32x4 g0 = acc[ai][0][m][0], g1 = acc[ai][0][m][1], u0 = acc[ai][1][m][0], u1 = acc[ai][1][m][1];
                float h[8];
#pragma unroll
                for (int j = 0; j < 4; ++j) { h[j] = g0[j] * fast_sigmoid(g0[j]) * u0[j]; h[4 + j] = g1[j] * fast_sigmoid(g1[j]) * u1[j]; }
                u32x4 w; w.x = cvt_pk_bf16(h[0], h[1]); w.y = cvt_pk_bf16(h[2], h[3]); w.z = cvt_pk_bf16(h[4], h[5]); w.w = cvt_pk_bf16(h[6], h[7]);
                *(u32x4*)(hp + (size_t)(ai * HALF + m * 16) * 64) = w;
            }
    }
};
template <bool LNIN> struct EpiResid {
    static constexpr bool PERM = false;
    const float* res_lat; const float* res_ctx; float* X; const float* gate_tab; float gscale;
    const float* stats; const float* lng; const float* lnb;
    float* part;
    __device__ __forceinline__ void operator()(const Acc& acc, const Unit& u, int wr, int wc, int fr, int fq) const {
        if (u.part >= 0) {
            float* pb = part + ((size_t)u.part * TC + (size_t)(u.pm - 128) * BM + wr * 64 + fr) * D + u.pn * BM + wc * 32 + 4 * fq;
#pragma unroll
            for (int ai = 0; ai < 2; ++ai)
#pragma unroll
                for (int m = 0; m < 4; ++m)
#pragma unroll
                    for (int bj = 0; bj < 2; ++bj)
#pragma unroll
                        for (int n = 0; n < 2; ++n) *(f32x4*)(pb + (size_t)(ai * HALF + m * 16) * D + bj * HALF + n * 16) = acc[ai][bj][m][n];
            return;
        }
        const int bidx = u.pm < 128 ? (u.pm >> 4) : 8;
        const int r0 = wr * 64 + fr, col0 = u.pn * BM + wc * 32 + 4 * fq;
        const float* gate = gate_tab + (size_t)bidx * NMOD + col0;
        const float* rbase = (u.pm < 128 ? res_lat + (size_t)u.pm * BM * D : res_ctx + (size_t)(u.pm - 128) * BM * D) + (size_t)r0 * D + col0;
        float* xbase = X + ((size_t)u.pm * BM + r0) * D + col0;
        const float* stp = stats + ((size_t)u.pm * BM + r0) * 2;
#pragma unroll
        for (int bj = 0; bj < 2; ++bj)
#pragma unroll
            for (int n = 0; n < 2; ++n) {
                const int co = bj * HALF + n * 16;
                const f32x4 gv = *(const f32x4*)(gate + co) * gscale;
                f32x4 ga = (f32x4){ALPHA, ALPHA, ALPHA, ALPHA}, ba = (f32x4){0.f, 0.f, 0.f, 0.f};
                if constexpr (LNIN) { ga = *(const f32x4*)(lng + col0 + co) * ALPHA; ba = *(const f32x4*)(lnb + col0 + co) * ALPHA; }
#pragma unroll
                for (int ai = 0; ai < 2; ++ai)
#pragma unroll
                    for (int m = 0; m < 4; ++m) { const int rr = ai * HALF + m * 16; const size_t ro = (size_t)rr * D + co;
                        f32x4 r = *(const f32x4*)(rbase + ro);
                        if constexpr (LNIN) { const f32x2 st = *(const f32x2*)(stp + rr * 2); r = (r - st.x) * st.y; }
                        *(f32x4*)(xbase + ro) = r * ga + ba + gv * acc[ai][bj][m][n]; }
                asm volatile("" ::: "memory"); }
    }
};
struct EpiQK {
    static constexpr bool PERM = true;
    bf16_t* Q; bf16_t* Kb; const float* tab;
    __device__ __forceinline__ void operator()(const Acc& acc, const Unit& u, int wr, int wc, int fr, int fq) const {
        const bool is_q = u.pn < 8, lat = u.pm < 128;
        bf16_t* dst = is_q ? Q : Kb;
        const int col0 = (u.pn & 7) * BM + wc * 32 + 8 * fq, row0 = u.pm * BM + wr * 64 + fr;
        const float sc = is_q ? QSCALE : 1.0f;
        const int ax = wc & 1;
#pragma unroll
        for (int ai = 0; ai < 2; ++ai) {
            const int prow = (4 * u.pm + 2 * ai + wr) & 63;
#pragma unroll
            for (int m = 0; m < 4; ++m) {
                const int pos = ax ? (16 * m + fr) : prow;
                f32x4 t0 = (f32x4){1.f, 0.f, 1.f, 0.f}, t1 = t0;
                if (lat) { const float* tp = tab + (size_t)(pos * 16 + 4 * fq) * 2; t0 = *(const f32x4*)tp; t1 = *(const f32x4*)(tp + 4); }
#pragma unroll
                for (int bj = 0; bj < 2; ++bj) {
                    const f32x4 v0 = acc[ai][bj][m][0], v1 = acc[ai][bj][m][1];
                    float o[8];
                    o[0] = v0[0] * t0[0] - v0[1] * t0[1]; o[1] = v0[0] * t0[1] + v0[1] * t0[0];
                    o[2] = v0[2] * t0[2] - v0[3] * t0[3]; o[3] = v0[2] * t0[3] + v0[3] * t0[2];
                    o[4] = v1[0] * t1[0] - v1[1] * t1[1]; o[5] = v1[0] * t1[1] + v1[1] * t1[0];
                    o[6] = v1[2] * t1[2] - v1[3] * t1[3]; o[7] = v1[2] * t1[3] + v1[3] * t1[2];
                    u32x4 w; w.x = cvt_pk_bf16(o[0] * sc, o[1] * sc); w.y = cvt_pk_bf16(o[2] * sc, o[3] * sc); w.z = cvt_pk_bf16(o[4] * sc, o[5] * sc); w.w = cvt_pk_bf16(o[6] * sc, o[7] * sc);
                    *(u32x4*)(dst + (size_t)(row0 + ai * HALF + m * 16) * D + col0 + bj * HALF) = w;
                }
            }
        }
    }
};
struct EpiBf16 {
    static constexpr bool PERM = true;
    bf16_t* O; int ldc;
    __device__ __forceinline__ void operator()(const Acc& acc, const Unit& u, int wr, int wc, int fr, int fq) const {
        const int row0 = u.pm * BM + wr * 64 + fr, col0 = u.pn * BM + wc * 32 + 8 * fq;
#pragma unroll
        for (int ai = 0; ai < 2; ++ai)
#pragma unroll
            for (int m = 0; m < 4; ++m) { bf16_t* rowp = O + (size_t)(row0 + ai * HALF + m * 16) * ldc + col0;
#pragma unroll
                for (int bj = 0; bj < 2; ++bj) { const f32x4 v0 = acc[ai][bj][m][0], v1 = acc[ai][bj][m][1];
                    u32x4 w; w.x = cvt_pk_bf16(v0[0], v0[1]); w.y = cvt_pk_bf16(v0[2], v0[3]); w.z = cvt_pk_bf16(v1[0], v1[1]); w.w = cvt_pk_bf16(v1[2], v1[3]);
                    *(u32x4*)(rowp + bj * HALF) = w; } }
    }
};
struct EpiWin {
    static constexpr bool PERM = true;
    bf16_t* GG; bf16_t* XR;
    __device__ __forceinline__ void operator()(const Acc& acc, const Unit& u, int wr, int wc, int fr, int fq) const {
        const bool isg = u.pn < 10;
        bf16_t* dst = isg ? GG : XR;
        const int row0 = u.pm * BM + wr * 64 + fr, col0 = (isg ? u.pn : u.pn - 10) * BM + wc * 32 + 8 * fq;
#pragma unroll
        for (int ai = 0; ai < 2; ++ai)
#pragma unroll
            for (int m = 0; m < 4; ++m) { bf16_t* rowp = dst + (size_t)(row0 + ai * HALF + m * 16) * DR + col0;
#pragma unroll
                for (int bj = 0; bj < 2; ++bj) { f32x4 v0 = acc[ai][bj][m][0], v1 = acc[ai][bj][m][1];
                    if (isg) {
#pragma unroll
                        for (int j = 0; j < 4; ++j) { const float x = v0[j], y = v1[j];
                            v0[j] = x * fast_sigmoid(1.5957691216057308f * (x + 0.044715f * x * x * x));
                            v1[j] = y * fast_sigmoid(1.5957691216057308f * (y + 0.044715f * y * y * y)); } }
                    u32x4 w; w.x = cvt_pk_bf16(v0[0], v0[1]); w.y = cvt_pk_bf16(v0[2], v0[3]); w.z = cvt_pk_bf16(v1[0], v1[1]); w.w = cvt_pk_bf16(v1[2], v1[3]);
                    *(u32x4*)(rowp + bj * HALF) = w; } }
    }
};
struct EpiGates {
    static constexpr bool PERM = true;
    const bf16_t* XC; const float* ba; const float* bi; const float* c8; unsigned short* AB; int q;
    __device__ __forceinline__ void operator()(const Acc& acc, const Unit& u, int wr, int wc, int fr, int fq) const {
        const int d = u.pn / 20, blk = (u.pn % 20) >> 1, half = u.pn & 1;
        const int ch0 = blk * 256 + half * 128 + wc * 32 + 8 * fq;
        const int gp = u.pm < 32 ? 32 * q + u.pm : 128 + 2 * q + (u.pm - 32);
        const int r0 = wr * 64 + fr;
        const bf16_t* xcp = XC + ((size_t)gp * BM + r0) * DR + ch0;
        unsigned short* A1 = AB + (size_t)(2 * d) * ((size_t)QROWS * DR) + ((size_t)u.pm * BM + r0) * DR + ch0;
        unsigned short* Bq = A1 + (size_t)QROWS * DR;
#pragma unroll
        for (int n = 0; n < 2; ++n) {
            const f32x4 bav = *(const f32x4*)(ba + d * DR + ch0 + 4 * n), biv = *(const f32x4*)(bi + d * DR + ch0 + 4 * n), cv = *(const f32x4*)(c8 + d * DR + ch0 + 4 * n);
#pragma unroll
            for (int ai = 0; ai < 2; ++ai)
#pragma unroll
                for (int m = 0; m < 4; ++m) {
                    const size_t ro = (size_t)(ai * HALF + m * 16) * DR + 4 * n;
                    const u32x2 xw = *(const u32x2*)(xcp + ro);
                    const float xc[4] = {bf_lo(xw.x), bf_hi(xw.x), bf_lo(xw.y), bf_hi(xw.y)};
                    f32x4 ga = acc[ai][0][m][n], gi = acc[ai][1][m][n];
                    asm volatile("" : "+v"(ga), "+v"(gi));
                    float am[4], bb[4];
#pragma unroll
                    for (int j = 0; j < 4; ++j) {
                        const float r = fast_sigmoid(ga[j] + bav[j]), ig = fast_sigmoid(gi[j] + biv[j]);
                        const float a = __builtin_amdgcn_exp2f(r * cv[j] * LOG2E);
                        const float a1 = 1.0f - a;
                        am[j] = a1; bb[j] = __builtin_sqrtf(a1 * (1.0f + a)) * ig * xc[j];
                    }
                    u32x2 wa, wb;
                    wa.x = pk_f16(am[0], am[1]); wa.y = pk_f16(am[2], am[3]); wb.x = pk_f16(bb[0], bb[1]); wb.y = pk_f16(bb[2], bb[3]);
                    *(u32x2*)(A1 + ro) = wa; *(u32x2*)(Bq + ro) = wb;
                    asm volatile("" ::: "memory");
                }
        }
    }
};
}

struct Params {
    const float* in[27];
    float* out;
    unsigned char* ws;
};

#define KAS __attribute__((address_space(4)))
__device__ __forceinline__ const float* ldparam(int k) { const KAS char* kp = (const KAS char*)__builtin_amdgcn_kernarg_segment_ptr(); asm volatile("" : "+s"(kp)); return *(const float* const KAS*)(kp + 8 * k); }
#define PIN(k) ldparam(k)
#define POUT() ((float*)ldparam(27))

struct Ctx {
    LAS unsigned char* lds;
    unsigned char* ws;
    int tid, lane, wave, vcu, G;
};

__device__ __forceinline__ Ctx fresh(const Ctx& C0) { Ctx R = C0; int l = lane_id(); int w = C0.wave; asm volatile("" : "+v"(l), "+s"(w)); R.lane = l; R.wave = w; R.tid = w * 64 + l; return R; }

template <bool QKPERM, int TKT = 0>
__device__ __forceinline__ void transpose_item(const float* W, int ldw, int k0, int n0, bf16_t* WT, int ldo, int orow0, LAS float* scr, int lane) {
    f32x4 ld[8];
#pragma unroll
    for (int i = 0; i < 8; ++i) ld[i] = *(const f32x4*)(W + (size_t)(k0 + 8 * i + (lane >> 3)) * ldw + n0 + 4 * (lane & 7));
#pragma unroll
    for (int i = 0; i < 8; ++i) { LAS float* d = scr + (8 * i + (lane >> 3)) * 33 + 4 * (lane & 7); d[0] = ld[i][0]; d[1] = ld[i][1]; d[2] = ld[i][2]; d[3] = ld[i][3]; }
    asm volatile("s_waitcnt lgkmcnt(0)" ::: "memory");
    const int c = lane & 7;
#pragma unroll
    for (int j = 0; j < 4; ++j) { const int n = (lane >> 3) + 8 * j; const LAS float* s = scr + (8 * c) * 33 + n;
        u32x4 o; o.x = pk2(s[0 * 33], s[1 * 33]); o.y = pk2(s[2 * 33], s[3 * 33]); o.z = pk2(s[4 * 33], s[5 * 33]); o.w = pk2(s[6 * 33], s[7 * 33]);
        const int np = QKPERM ? (2 * (n & 15) + (n >> 4)) : n;
        if constexpr (TKT > 0) { const int orow = orow0 + np; *(u32x4*)(WT + ((size_t)((orow >> 8) * TKT + (k0 >> 6)) * 256 + (orow & 255)) * 64 + 8 * c) = o; }
        else *(u32x4*)(WT + (size_t)(orow0 + np) * ldo + k0 + 8 * c) = o; }
    asm volatile("s_waitcnt lgkmcnt(0)" ::: "memory");
}

namespace wc {
constexpr int I_G = 32 * 176, I_D = 88 * 64, I_QK = 32 * 128, I_V = 32 * 64, I_O = 32 * 64, I_IN = 32 * 160, I_A = 20 * 32, I_OUT = 40 * 64;
constexpr int GU0 = 0, WD0 = 8 * I_G, ATT0 = WD0 + 4 * I_D, LRU0 = ATT0 + I_QK + I_V + I_O, NITEMS = LRU0 + I_IN + 2 * I_A + I_OUT;
}
__device__ __forceinline__ void convert_weights(const Ctx& C0, const Params& P, int lo, int hi, int widx, int wcount) {
    const Ctx C = fresh(C0);
    using namespace wc;
    LAS float* scr = (LAS float*)(C.lds + C.wave * 16384);
    bf16_t* Wgu = (bf16_t*)(C.ws + WS_WGU); bf16_t* Wd = (bf16_t*)(C.ws + WS_WD);
    for (int it = lo + widx; it < hi; it += wcount) {
        int r = it;
        if (r < 8 * I_G) {
            const int lf = r / (2 * I_G); r -= lf * 2 * I_G; const int which = r / I_G; r -= which * I_G;
            const int kb = r / 176, nb = r % 176, n0 = nb * 32;
            const float* W = (which ? PIN(9) : PIN(8)) + (size_t)lf * D * FF;
            transpose_item<false, 32>(W, FF, kb * 64, n0, Wgu + (size_t)lf * 11264 * WP2, WP2, 256 * (n0 >> 7) + (n0 & 127) + which * 128, scr, C.lane);
            continue; }
        r -= 8 * I_G;
        if (r < 4 * I_D) { const int lf = r / I_D; r -= lf * I_D; const int kb = r / 64, nb = r % 64;
            transpose_item<false, 88>(PIN(10) + (size_t)lf * FF * D, D, kb * 64, nb * 32, Wd + (size_t)lf * D * WP5, WP5, nb * 32, scr, C.lane); continue; }
        r -= 4 * I_D;
        if (r < I_QK) { const int kb = r / 128, nb = r % 128;
            transpose_item<true>(PIN(11), 3 * D, kb * 64, nb * 32, (bf16_t*)(C.ws + WS_WQK), WP2, nb * 32, scr, C.lane); continue; }
        r -= I_QK;
        if (r < I_V) { const int kb = r / 64, nb = r % 64;
            transpose_item<false>(PIN(11), 3 * D, kb * 64, 2 * D + nb * 32, (bf16_t*)(C.ws + WS_WV), WP2, nb * 32, scr, C.lane); continue; }
        r -= I_V;
        if (r < I_O) { const int kb = r / 64, nb = r % 64;
            transpose_item<false>(PIN(12), D, kb * 64, nb * 32, (bf16_t*)(C.ws + WS_WO), WP2, nb * 32, scr, C.lane); continue; }
        r -= I_O;
        if (r < I_IN) { const int kb = r / 160, nb = r % 160;
            transpose_item<false>(PIN(18), 2 * DR, kb * 64, nb * 32, (bf16_t*)(C.ws + WS_WIN), WP2, nb * 32, scr, C.lane); continue; }
        r -= I_IN;
        if (r < 2 * I_A) { const int which = r / I_A; r -= which * I_A; const int mat = r / 32; r -= mat * 32; const int kb = r / 8, nb = r % 8, n0 = nb * 32;
            const float* W = (which ? PIN(23) : PIN(21)) + (size_t)mat * 256 * 256;
            transpose_item<false>(W, 256, kb * 64, n0, (bf16_t*)(C.ws + WS_WAI), 256, (mat * 2 + (n0 >> 7)) * 256 + (n0 & 127) + which * 128, scr, C.lane); continue; }
        r -= 2 * I_A;
        { const int kb = r / 64, nb = r % 64;
            transpose_item<false>(PIN(26), D, kb * 64, nb * 32, (bf16_t*)(C.ws + WS_WOUT), WPR, nb * 32, scr, C.lane); }
    }
}

__device__ __forceinline__ void convert_in_tail(const Ctx& C, const Params& P, int nunits, int lo, int hi) {
    const int rem = nunits % C.G, cid = (int)blockIdx.x;
    if (rem == 0) convert_weights(C, P, lo, hi, cid * 8 + C.wave, C.G * 8);
    else if (cid >= rem) convert_weights(C, P, lo, hi, (cid - rem) * 8 + C.wave, (C.G - rem) * 8);
}

__device__ __forceinline__ void prologue_mod(const Ctx& C0, const Params& P, int layer, int wgi, int wgn) {
    const Ctx C = fresh(C0);
    LAS float* sc = (LAS float*)C.lds;
    LAS float* red = (LAS float*)(C.lds + 9 * 2048 * 4);
    for (int idx = C.tid; idx < 9 * D; idx += 512) { const int bidx = idx >> 11, k = idx & 2047; const float cv = bidx < 8 ? PIN(1)[bidx * D + k] : PIN(3)[k]; sc[idx] = cv / (1.0f + __expf(-cv)); }
    __syncthreads();
    float* MOD = (float*)(C.ws + WS_MOD);
    for (int item = wgi; item < 144; item += wgn) {
        const int n0 = item * 128;
        const float* W = PIN(4) + (size_t)layer * D * NMOD + n0 + 2 * C.lane;
        float a0[9], a1[9];
#pragma unroll
        for (int b = 0; b < 9; ++b) { a0[b] = 0.f; a1[b] = 0.f; }
        const int kbeg = C.wave * 256;
#pragma unroll 8
        for (int k = kbeg; k < kbeg + 256; ++k) {
            const f32x2 w = *(const f32x2*)(W + (size_t)k * NMOD);
#pragma unroll
            for (int b = 0; b < 9; ++b) { const float s = sc[b * 2048 + k]; a0[b] += s * w.x; a1[b] += s * w.y; }
        }
#pragma unroll
        for (int b = 0; b < 9; ++b) { red[(C.wave * 9 + b) * 128 + 2 * C.lane] = a0[b]; red[(C.wave * 9 + b) * 128 + 2 * C.lane + 1] = a1[b]; }
        __syncthreads();
        for (int idx = C.tid; idx < 9 * 128; idx += 512) { const int b = idx >> 7, col = idx & 127; float s = 0.f;
#pragma unroll
            for (int w = 0; w < 8; ++w) s += red[(w * 9 + b) * 128 + col];
            MOD[((size_t)layer * 9 + b) * NMOD + n0 + col] = s + PIN(5)[layer * NMOD + n0 + col]; }
        __syncthreads();
    }
}

__device__ __forceinline__ void prologue_small(const Ctx& C0, const Params& P) {
    const Ctx C = fresh(C0);
    if (C.vcu == 0) {
        float* tab = (float*)(C.ws + WS_TAB);
        for (int idx = C.tid; idx < 64 * 16; idx += 512) { const int pos = idx >> 4, j = idx & 15;
            const float inv = powf(10000.0f, -(float)(2 * j) / 32.0f); const float ang = (float)pos * inv;
            tab[2 * idx] = cosf(ang); tab[2 * idx + 1] = sinf(ang); }
        if (C.tid == 0) { float s1 = 0.f, s2 = 0.f; for (int i = 0; i < 64; ++i) { s1 += PIN(13)[i] * PIN(14)[i]; s2 += PIN(15)[i] * PIN(16)[i]; }
            *(float*)(C.ws + WS_LAM) = expf(s1) - expf(s2) + 0.2f; }
    }
    if (C.vcu == 1) {
        float* c8 = (float*)(C.ws + WS_C8);
        for (int idx = C.tid; idx < 2 * DR; idx += 512) { const float ap = PIN(25)[idx]; c8[idx] = -8.0f * log1pf(expf(-ap)); }
    }
}

__device__ __forceinline__ void prep_phase(const Ctx& C0, const Params& P) {
    const Ctx C = fresh(C0);
    const float* MOD = (const float*)(C.ws + WS_MOD);
    bf16_t* U = (bf16_t*)(C.ws + WS_U);
    const int gw = C.vcu * 8 + C.wave, NGW = C.G * 8;
    const float* xin = PIN(0); const float* cin = PIN(2);
    f32x4 xv[8], nx[8];
    if (gw < T) { const float* xr = (gw < TL ? xin + (size_t)gw * D : cin + (size_t)(gw - TL) * D) + 4 * C.lane;
#pragma unroll
        for (int j = 0; j < 8; ++j) xv[j] = *(const f32x4*)(xr + 256 * j); }
    for (int row = gw; row < T; row += NGW) {
        const int bidx = row < TL ? (row >> 12) : 8;
        const int nrow = row + NGW;
        if (nrow < T) { const float* xr = (nrow < TL ? xin + (size_t)nrow * D : cin + (size_t)(nrow - TL) * D) + 4 * C.lane;
#pragma unroll
            for (int j = 0; j < 8; ++j) nx[j] = *(const f32x4*)(xr + 256 * j); }
        const float* sh = MOD + (size_t)bidx * NMOD + 4 * C.lane; const float* scl = sh + D;
#pragma unroll
        for (int j = 0; j < 8; ++j) { const f32x4 v = xv[j], s4 = *(const f32x4*)(sh + 256 * j), c4 = *(const f32x4*)(scl + 256 * j);
            const f32x4 o = v * (c4 + 1.0f) + s4; u32x2 w; w.x = cvt_pk_bf16(o[0], o[1]); w.y = cvt_pk_bf16(o[2], o[3]);
            *(u32x2*)(U + (size_t)row * D + 256 * j + 4 * C.lane) = w; }
#pragma unroll
        for (int j = 0; j < 8; ++j) xv[j] = nx[j];
    }
}

struct CtxComb { const float* part; const float* res_raw; const float* pg; const float* pb; const float* gate; float gscale; bool on; };
__device__ __forceinline__ void ln_phase(const Ctx& C0, int M, const float* lng, const float* lnb, const float* modn  , bf16_t* U, float* out, const CtxComb cc) {
    const Ctx C = fresh(C0);
    float* X = (float*)(C.ws + WS_X);
    f32x2* ST = (f32x2*)(C.ws + WS_STATS);
    const int gw = C.vcu * 8 + C.wave, NGW = C.G * 8;
    f32x4 g[8], b[8];
#pragma unroll
    for (int j = 0; j < 8; ++j) { g[j] = *(const f32x4*)(lng + 256 * j + 4 * C.lane); b[j] = *(const f32x4*)(lnb + 256 * j + 4 * C.lane); }
    f32x4 v[8], nv[8]; bool have = false;
    if (gw < M && !(cc.on && gw >= TL)) { const float* xp = X + (size_t)gw * D + 4 * C.lane;
#pragma unroll
        for (int j = 0; j < 8; ++j) v[j] = *(const f32x4*)(xp + 256 * j);
        have = true; }
    for (int row = gw; row < M; row += NGW) {
        float* xr = X + (size_t)row * D + 4 * C.lane;
        float s = 0.f;
        const int nrow = row + NGW; const bool nhave = nrow < M && !(cc.on && nrow >= TL);
        if (nhave) { const float* xp = X + (size_t)nrow * D + 4 * C.lane;
#pragma unroll
            for (int j = 0; j < 8; ++j) nv[j] = *(const f32x4*)(xp + 256 * j); }
        if (have) {   } else if (cc.on && row >= TL) {
            const size_t co = (size_t)(row - TL) * D + 4 * C.lane;
            f32x2 ost = (f32x2){0.f, 1.f}; if (!cc.res_raw) ost = ST[row];
#pragma unroll
            for (int j = 0; j < 8; ++j) { const float* pp = cc.part + co + 256 * j;
                const f32x4 sum = (*(const f32x4*)pp + *(const f32x4*)(pp + (size_t)TC * D)) + (*(const f32x4*)(pp + (size_t)2 * TC * D) + *(const f32x4*)(pp + (size_t)3 * TC * D));
                f32x4 r;
                if (cc.res_raw) r = *(const f32x4*)(cc.res_raw + co + 256 * j);
                else r = (*(const f32x4*)(xr + 256 * j) - ost.x) * ost.y * *(const f32x4*)(cc.pg + 256 * j + 4 * C.lane) + *(const f32x4*)(cc.pb + 256 * j + 4 * C.lane);
                v[j] = r * ALPHA + *(const f32x4*)(cc.gate + 256 * j + 4 * C.lane) * cc.gscale * sum;
                *(f32x4*)(xr + 256 * j) = v[j]; }
        } else {
#pragma unroll
            for (int j = 0; j < 8; ++j) v[j] = *(const f32x4*)(xr + 256 * j);
        }
#pragma unroll
        for (int j = 0; j < 8; ++j) s += (v[j][0] + v[j][1]) + (v[j][2] + v[j][3]);
        const float mean = wave_sum(s) * (1.0f / D); float s2 = 0.f;
#pragma unroll
        for (int j = 0; j < 8; ++j) { v[j] = v[j] - mean; s2 += (v[j][0] * v[j][0] + v[j][1] * v[j][1]) + (v[j][2] * v[j][2] + v[j][3] * v[j][3]); }
        const float rstd = 1.0f / sqrtf(wave_sum(s2) * (1.0f / D) + LN_EPS);
        if (C.lane == 0) ST[row] = (f32x2){mean, rstd};
#pragma unroll
        for (int j = 0; j < 8; ++j) v[j] = v[j] * rstd * g[j] + b[j];
        if (out) {
#pragma unroll
            for (int j = 0; j < 8; ++j) *(f32x4*)(out + (size_t)row * D + 256 * j + 4 * C.lane) = v[j];
        }
        if (modn) {
            const int bidx = row < TL ? (row >> 12) : 8;
            const float* sh = modn + (size_t)bidx * NMOD + 4 * C.lane; const float* scl = sh + D;
#pragma unroll
            for (int j = 0; j < 8; ++j) { const f32x4 s4 = *(const f32x4*)(sh + 256 * j), c4 = *(const f32x4*)(scl + 256 * j);
                const f32x4 o = v[j] * (c4 + 1.0f) + s4; u32x2 w; w.x = cvt_pk_bf16(o[0], o[1]); w.y = cvt_pk_bf16(o[2], o[3]);
                *(u32x2*)(U + (size_t)row * D + 256 * j + 4 * C.lane) = w; }
        }
#pragma unroll
        for (int j = 0; j < 8; ++j) v[j] = nv[j];
        have = nhave;
    }
}

namespace att {
constexpr int SLOT = 16384, LDS_K = 0, LDS_V = 4 * SLOT;
#define ATT_SBAR() __builtin_amdgcn_sched_barrier(0)
__device__ __forceinline__ float rowmax32(const f32x16& a, const f32x16& b) {
    float x = __builtin_fmaxf(__builtin_fmaxf(a[0], a[1]), b[0]), y = __builtin_fmaxf(__builtin_fmaxf(a[2], a[3]), b[1]);
    x = __builtin_fmaxf(__builtin_fmaxf(x, b[2]), b[3]);
#pragma unroll
    for (int r = 4; r < 16; r += 4) { x = __builtin_fmaxf(__builtin_fmaxf(x, a[r]), a[r + 1]); y = __builtin_fmaxf(__builtin_fmaxf(y, a[r + 2]), a[r + 3]); x = __builtin_fmaxf(__builtin_fmaxf(x, b[r]), b[r + 1]); y = __builtin_fmaxf(__builtin_fmaxf(y, b[r + 2]), b[r + 3]); }
    float m = __builtin_fmaxf(x, y);
    auto rr = __builtin_amdgcn_permlane32_swap(__float_as_uint(m), __float_as_uint(m), false, false);
    return __builtin_fmaxf(__uint_as_float(rr[0]), __uint_as_float(rr[1]));
}
__device__ __forceinline__ float halfsum(float x) { auto rr = __builtin_amdgcn_permlane32_swap(__float_as_uint(x), __float_as_uint(x), false, false); return __uint_as_float(rr[0]) + __uint_as_float(rr[1]); }
__device__ __forceinline__ void unit(const Ctx& C, const bf16_t* Q, const bf16_t* Kb, const bf16_t* VT, bf16_t* O, int qrow0, int h, int NT, int krow_ctx, int krow_lat, const float* lamp, const float* subg) {
    int lane = lane_id(); asm volatile("" : "+v"(lane));
    int wid = C.wave; asm volatile("" : "+s"(wid));
    const int l32 = lane & 31, hi = lane >> 5, qsub = wid >> 1, e = wid & 1;
    LAS unsigned char* lds = C.lds;
    unsigned koffl[2], voffl[2];
#pragma unroll
    for (int j = 0; j < 2; ++j) { const int p = 2 * wid + j;
        { const int r = 4 * p + (lane >> 4), c = (lane & 15) ^ (r & 15); koffl[j] = (unsigned)(r * D + h * 128 + c * 8) * 2u; }
        { const int v = 8 * p + (lane >> 3), c = (lane & 7) ^ ((v >> 1) & 7); voffl[j] = (unsigned)((h * 128 + v) * T + c * 8) * 2u; } }
#define ATT_KROW(t) ((t) < 4 ? krow_ctx + 64 * (t) : krow_lat + 64 * ((t) - 4))
#define ATT_DMA_K(t, slot) do { const char* b_ = (const char*)Kb + (size_t)ATT_KROW(t) * (D * 2); const int d_ = LDS_K + (slot) * SLOT + wid * 2048; \
        __builtin_amdgcn_global_load_lds((const unsigned*)(b_ + koffl[0]), (LAS unsigned*)(lds + d_), 16, 0, 0); \
        __builtin_amdgcn_global_load_lds((const unsigned*)(b_ + koffl[1]), (LAS unsigned*)(lds + d_ + 1024), 16, 0, 0); } while (0)
#define ATT_DMA_V(t, slotoff) do { const char* b_ = (const char*)VT + (size_t)ATT_KROW(t) * 2; const int d_ = LDS_V + (slotoff) + wid * 2048; \
        __builtin_amdgcn_global_load_lds((const unsigned*)(b_ + voffl[0]), (LAS unsigned*)(lds + d_), 16, 0, 0); \
        __builtin_amdgcn_global_load_lds((const unsigned*)(b_ + voffl[1]), (LAS unsigned*)(lds + d_ + 1024), 16, 0, 0); } while (0)
#define ATT_WAIT_BAR(N) do { asm volatile("" ::: "memory"); __builtin_amdgcn_s_waitcnt(0x0070 | (N)); asm volatile("s_barrier" ::: "memory"); } while (0)
    bf16x8 qf[4];
    { const bf16_t* qp = Q + (size_t)(qrow0 + 32 * qsub + l32) * D + h * 128 + e * 64 + 8 * hi;
#pragma unroll
      for (int ds = 0; ds < 4; ++ds) qf[ds] = *(const bf16x8*)(qp + 16 * ds); }
    ATT_DMA_K(0, 0); ATT_DMA_K(1, 1); ATT_DMA_K(2, 2); ATT_DMA_V(0, 0); ATT_DMA_K(3, 3); ATT_DMA_V(1, SLOT);
    const int pil = (l32 & ~12) | ((l32 & 4) << 1) | ((l32 & 8) >> 1);
    int kofs[4], vofs[4];
#pragma unroll
    for (int ds = 0; ds < 4; ++ds) kofs[ds] = LDS_K + pil * 256 + (((e * 8 + ds * 2 + hi) ^ (pil & 15)) << 4);
#pragma unroll
    for (int ks = 0; ks < 4; ++ks) vofs[ks] = LDS_V + l32 * 128 + (((2 * ks + hi) ^ ((l32 >> 1) & 7)) << 4);
#define ATT_KLD(dst, slot) do { _Pragma("unroll") for (int ds_ = 0; ds_ < 4; ++ds_) { dst[2 * ds_] = *(const LAS bf16x8*)(lds + (slot) * SLOT + kofs[ds_]); dst[2 * ds_ + 1] = *(const LAS bf16x8*)(lds + (slot) * SLOT + kofs[ds_] + 8192); } } while (0)
    f32x16 o[4];
#pragma unroll
    for (int vt = 0; vt < 4; ++vt)
#pragma unroll
        for (int r = 0; r < 16; ++r) o[vt][r] = 0.f;
    f32x16 negm;
    float mrow = 0.f, lsum = 0.f;
    bf16x8 kf[8];
    u32x4 pwA[4], pwB[4];
    f32x16 c0, c1;
    ATT_WAIT_BAR(8);
    ATT_KLD(kf, 0);
#pragma unroll
    for (int ds = 0; ds < 4; ++ds) { const f32x16 z16 = {0.f, 0.f, 0.f, 0.f, 0.f, 0.f, 0.f, 0.f, 0.f, 0.f, 0.f, 0.f, 0.f, 0.f, 0.f, 0.f};
        c0 = __builtin_amdgcn_mfma_f32_32x32x16_bf16(kf[2 * ds], qf[ds], ds == 0 ? z16 : c0, 0, 0, 0); c1 = __builtin_amdgcn_mfma_f32_32x32x16_bf16(kf[2 * ds + 1], qf[ds], ds == 0 ? z16 : c1, 0, 0, 0); }
    ATT_KLD(kf, 1);
    { const float rm = rowmax32(c0, c1); mrow = rm;
#pragma unroll
      for (int r = 0; r < 16; ++r) negm[r] = -mrow;
      asm volatile("" : "+v"(negm));
      float ps = 0.f;
#pragma unroll
      for (int r = 0; r < 16; ++r) { c0[r] = __builtin_amdgcn_exp2f(c0[r] - rm); c1[r] = __builtin_amdgcn_exp2f(c1[r] - rm); ps += c0[r] + c1[r]; }
      lsum = ps;
      pwA[0] = (u32x4){cvt_pk_bf16(c0[0], c0[1]), cvt_pk_bf16(c0[2], c0[3]), cvt_pk_bf16(c0[4], c0[5]), cvt_pk_bf16(c0[6], c0[7])};
      pwA[1] = (u32x4){cvt_pk_bf16(c0[8], c0[9]), cvt_pk_bf16(c0[10], c0[11]), cvt_pk_bf16(c0[12], c0[13]), cvt_pk_bf16(c0[14], c0[15])};
      pwA[2] = (u32x4){cvt_pk_bf16(c1[0], c1[1]), cvt_pk_bf16(c1[2], c1[3]), cvt_pk_bf16(c1[4], c1[5]), cvt_pk_bf16(c1[6], c1[7])};
      pwA[3] = (u32x4){cvt_pk_bf16(c1[8], c1[9]), cvt_pk_bf16(c1[10], c1[11]), cvt_pk_bf16(c1[12], c1[13]), cvt_pk_bf16(c1[14], c1[15])}; }
    int vs_prev = 0, vs_cur = SLOT, vs_next = 2 * SLOT;
#define ATT_ROT() do { const int t_ = vs_prev; vs_prev = vs_cur; vs_cur = vs_next; vs_next = t_; } while (0)
#define ATT_PEL(i) ((i) < 16 ? c0[(i) & 15] : c1[(i) & 15])
#define ATT_GAPB(g, VT_, VF, PWC, PWN, CV) do { o[VT_] = __builtin_amdgcn_mfma_f32_32x32x16_bf16(VF, __builtin_bit_cast(bf16x8, PWC[(g) >> 2]), o[VT_], 0, 0, 0); \
        { const float a_ = __builtin_amdgcn_exp2f(CV[(2 * (g)) & 15]), b_ = __builtin_amdgcn_exp2f(CV[(2 * (g) + 1) & 15]); \
          CV[(2 * (g)) & 15] = a_; CV[(2 * (g) + 1) & 15] = b_; lacc += a_; lacc += b_; PWN[(g) >> 2][(g) & 3] = cvt_pk_bf16(a_, b_); } ATT_SBAR(); } while (0)
#define ATT_VLD(dst, ks_) do { _Pragma("unroll") for (int vt_ = 0; vt_ < 4; ++vt_) dst[vt_] = *(const LAS bf16x8*)(vp_ + vofs[ks_] + vt_ * 4096); } while (0)
#define ATT_KLDH(dst, slot, h_) do { _Pragma("unroll") for (int ds_ = 2 * (h_); ds_ < 2 * (h_) + 2; ++ds_) { dst[2 * ds_] = *(const LAS bf16x8*)(lds + (slot) * SLOT + kofs[ds_]); dst[2 * ds_ + 1] = *(const LAS bf16x8*)(lds + (slot) * SLOT + kofs[ds_] + 8192); } } while (0)
#define ATT_STEP(PWC, PWN, T_, KREAD) do { \
        ATT_WAIT_BAR(4); \
        const LAS unsigned char* vp_ = lds + vs_prev; \
        bf16x8 vf0[4], vf1[4]; \
        ATT_VLD(vf0, 0); \
        ATT_SBAR(); \
        _Pragma("unroll") for (int ds_ = 0; ds_ < 4; ++ds_) { c0 = __builtin_amdgcn_mfma_f32_32x32x16_bf16(kf[2 * ds_], qf[ds_], ds_ == 0 ? negm : c0, 0, 0, 0); c1 = __builtin_amdgcn_mfma_f32_32x32x16_bf16(kf[2 * ds_ + 1], qf[ds_], ds_ == 0 ? negm : c1, 0, 0, 0); } \
        ATT_SBAR(); \
        { const int tk_ = (T_) + 3 < NT ? (T_) + 3 : NT - 1, tv_ = (T_) + 1 < NT ? (T_) + 1 : NT - 1; ATT_DMA_K(tk_, ((T_) + 3) & 3); ATT_DMA_V(tv_, vs_next); }     \
        ATT_SBAR(); \
        float fresc = 1.0f; bool resc = false; \
        { const float rm_ = rowmax32(c0, c1); \
          if (__builtin_expect(__any(rm_ > 8.0f), 0)) { const float dl_ = __builtin_fmaxf(rm_, 0.f); mrow += dl_; \
              _Pragma("unroll") for (int r_ = 0; r_ < 16; ++r_) { c0[r_] -= dl_; c1[r_] -= dl_; } \
              _Pragma("unroll") for (int r_ = 0; r_ < 16; ++r_) negm[r_] = -mrow; \
              asm volatile("" : "+v"(negm)); \
              fresc = __builtin_amdgcn_exp2f(-dl_); lsum *= fresc; resc = true; } } \
        ATT_SBAR(); \
        float lacc = 0.f; \
          \
        ATT_GAPB(0, 0, vf0[0], PWC, PWN, c0); ATT_VLD(vf1, 1); ATT_SBAR(); ATT_GAPB(1, 1, vf0[1], PWC, PWN, c0); ATT_GAPB(2, 2, vf0[2], PWC, PWN, c0); ATT_GAPB(3, 3, vf0[3], PWC, PWN, c0); \
        ATT_GAPB(4, 0, vf1[0], PWC, PWN, c0); ATT_VLD(vf0, 2); ATT_SBAR(); ATT_GAPB(5, 1, vf1[1], PWC, PWN, c0); ATT_GAPB(6, 2, vf1[2], PWC, PWN, c0); ATT_GAPB(7, 3, vf1[3], PWC, PWN, c0); \
        ATT_GAPB(8, 0, vf0[0], PWC, PWN, c1); ATT_VLD(vf1, 3); if (KREAD) { ATT_KLDH(kf, ((T_) + 1) & 3, 0); } ATT_SBAR(); ATT_GAPB(9, 1, vf0[1], PWC, PWN, c1); ATT_GAPB(10, 2, vf0[2], PWC, PWN, c1); ATT_GAPB(11, 3, vf0[3], PWC, PWN, c1); \
        ATT_GAPB(12, 0, vf1[0], PWC, PWN, c1); if (KREAD) { ATT_KLDH(kf, ((T_) + 1) & 3, 1); } ATT_SBAR(); ATT_GAPB(13, 1, vf1[1], PWC, PWN, c1); ATT_GAPB(14, 2, vf1[2], PWC, PWN, c1); ATT_GAPB(15, 3, vf1[3], PWC, PWN, c1); \
        lsum += lacc; \
        if (resc) { _Pragma("unroll") for (int vt_ = 0; vt_ < 4; ++vt_) _Pragma("unroll") for (int r_ = 0; r_ < 16; ++r_) o[vt_][r_] *= fresc; } \
        ATT_ROT(); \
    } while (0)
    int t = 1;
    for (; t + 2 < NT; t += 2) { ATT_STEP(pwA, pwB, t, true); ATT_STEP(pwB, pwA, t + 1, true); }
    ATT_STEP(pwA, pwB, t, false);
    ATT_WAIT_BAR(4);
    { const LAS unsigned char* vp_ = lds + vs_prev;
#pragma unroll
      for (int vt = 0; vt < 4; ++vt)
#pragma unroll
          for (int ks = 0; ks < 4; ++ks) { const bf16x8 vf = *(const LAS bf16x8*)(vp_ + vofs[ks] + vt * 4096);
              o[vt] = __builtin_amdgcn_mfma_f32_32x32x16_bf16(vf, __builtin_bit_cast(bf16x8, pwB[ks]), o[vt], 0, 0, 0); } }
    ATT_WAIT_BAR(0);
    const float ltot = halfsum(lsum);
    const float inv = 1.0f / ltot;
    LAS float* ex = (LAS float*)(lds + qsub * 16384);
    if (e == 1) {
        const float f = inv * *lamp;
#pragma unroll
        for (int vt = 0; vt < 4; ++vt)
#pragma unroll
            for (int r = 0; r < 16; ++r) { const int v = 32 * vt + (r & 3) + 8 * (r >> 2) + 4 * hi; ex[v * 32 + l32] = o[vt][r] * f; }
    }
    __syncthreads();
    if (e == 0) {
        float ss = 0.f;
#pragma unroll
        for (int vt = 0; vt < 4; ++vt)
#pragma unroll
            for (int r = 0; r < 16; ++r) { const int v = 32 * vt + (r & 3) + 8 * (r >> 2) + 4 * hi; const float d = o[vt][r] * inv - ex[v * 32 + l32]; o[vt][r] = d; ss += d * d; }
        ss = halfsum(ss);
        const float rs = 0.8f / sqrtf(ss * (1.0f / 128.0f) + LN_EPS);
        asm volatile("s_waitcnt lgkmcnt(0)" ::: "memory");
        LAS unsigned char* st = (LAS unsigned char*)ex;
        const float* sgp = subg; asm volatile("" : "+s"(sgp));
#pragma unroll
        for (int vt = 0; vt < 4; ++vt)
#pragma unroll
            for (int rg = 0; rg < 4; ++rg) { const int v = 32 * vt + 8 * rg + 4 * hi; const f32x4 gg = *(const f32x4*)(sgp + v);
                u32x2 w; w.x = cvt_pk_bf16(o[vt][4 * rg] * rs * gg[0], o[vt][4 * rg + 1] * rs * gg[1]); w.y = cvt_pk_bf16(o[vt][4 * rg + 2] * rs * gg[2], o[vt][4 * rg + 3] * rs * gg[3]);
                *(LAS u32x2*)(st + l32 * 272 + v * 2) = w; }
        asm volatile("s_waitcnt lgkmcnt(0)" ::: "memory");
#pragma unroll
        for (int i = 0; i < 8; ++i) { const int c = lane + 64 * i, row = c >> 4, cg = c & 15;
            const u32x4 v = *(const LAS u32x4*)(st + row * 272 + cg * 16);
            *(u32x4*)(O + (size_t)(qrow0 + 32 * qsub + row) * D + h * 128 + cg * 8) = v; }
    }
    asm volatile("s_waitcnt vmcnt(0)" ::: "memory");
    __syncthreads();
#undef ATT_KROW
#undef ATT_DMA_K
#undef ATT_DMA_V
#undef ATT_WAIT_BAR
#undef ATT_KLD
#undef ATT_ROT
#undef ATT_PEL
#undef ATT_GAPB
#undef ATT_VLD
#undef ATT_KLDH
#undef ATT_STEP
}
}

__device__ __forceinline__ void attn_phase(const Ctx& C, const float* subg) {
    const bf16_t* Q = (const bf16_t*)(C.ws + WS_Q); const bf16_t* Kb = (const bf16_t*)(C.ws + WS_K); const bf16_t* VT = (const bf16_t*)(C.ws + WS_VT);
    bf16_t* O = (bf16_t*)(C.ws + WS_O);
    const float* lamp = (const float*)(C.ws + WS_LAM);
    const int bx = blockIdx.x, G = C.G;
    for (int i = 0; i * G + bx < 4096; ++i) {
        const int uidx = i * G + bx;
        const int bh = (G == 256) ? (bx & 7) + 8 * i : (uidx >> 5), qb = (G == 256) ? (bx >> 3) : (uidx & 31);
        const int b = bh >> 4, h = bh & 15;
        att::unit(C, Q, Kb, VT, O, b * SEQ + qb * 128, h, 68, TL + b * CTXL, b * SEQ, lamp, subg);
    }
    for (int uidx = bx; uidx < 256; uidx += G) { const int bh = uidx >> 1, b = bh >> 4, h = bh & 15;
        att::unit(C, Q, Kb, VT, O, TL + b * CTXL + (uidx & 1) * 128, h, 4, TL + b * CTXL, 0, lamp, subg); }
}

__device__ __forceinline__ void conv_phase(const Ctx& C0, const float* cw, const float* cb) {
    const Ctx C = fresh(C0);
    const bf16_t* XR = (const bf16_t*)(C.ws + WS_XR); bf16_t* XC = (bf16_t*)(C.ws + WS_XC);
    const int gw = C.vcu * 8 + C.wave, NGW = C.G * 8;
    constexpr int NRB = T / 32;
    for (int item = gw; item < NRB * 5; item += NGW) {
        const int rb = item / 5, cg = item % 5, ch = cg * 512 + 8 * C.lane, r0_ = rb * 32;
        const int seglen = r0_ < TL ? SEQ : CTXL; const int sbase = r0_ < TL ? (r0_ & ~(SEQ - 1)) : TL + ((r0_ - TL) & ~(CTXL - 1));
        const int s0 = r0_ - sbase;
        float w[4][8], bias[8];
#pragma unroll
        for (int j = 0; j < 4; ++j) { const f32x4 a = *(const f32x4*)(cw + j * DR + ch), b = *(const f32x4*)(cw + j * DR + ch + 4);
#pragma unroll
            for (int k = 0; k < 4; ++k) { w[j][k] = a[k]; w[j][4 + k] = b[k]; } }
        { const f32x4 a = *(const f32x4*)(cb + ch), b = *(const f32x4*)(cb + ch + 4);
#pragma unroll
          for (int k = 0; k < 4; ++k) { bias[k] = a[k]; bias[4 + k] = b[k]; } }
        u32x4 rw[35];
#pragma unroll
        for (int i = 0; i < 35; ++i) { const int s_ = s0 + i - 2; rw[i] = (u32x4){0u, 0u, 0u, 0u}; if (s_ >= 0 && s_ < seglen) rw[i] = *(const u32x4*)(XR + (size_t)(sbase + s_) * DR + ch); }
#define CV_UNP(dst, x_) do { dst[0] = bf_lo(x_.x); dst[1] = bf_hi(x_.x); dst[2] = bf_lo(x_.y); dst[3] = bf_hi(x_.y); dst[4] = bf_lo(x_.z); dst[5] = bf_hi(x_.z); dst[6] = bf_lo(x_.w); dst[7] = bf_hi(x_.w); } while (0)
#pragma unroll
        for (int i = 0; i < 32; ++i) {
            float r0[8], r1[8], r2[8], r3[8], o[8];
            CV_UNP(r0, rw[i]); CV_UNP(r1, rw[i + 1]); CV_UNP(r2, rw[i + 2]); CV_UNP(r3, rw[i + 3]);
#pragma unroll
            for (int k = 0; k < 8; ++k) o[k] = bias[k] + w[0][k] * r0[k] + w[1][k] * r1[k] + w[2][k] * r2[k] + w[3][k] * r3[k];
            u32x4 ow; ow.x = cvt_pk_bf16(o[0], o[1]); ow.y = cvt_pk_bf16(o[2], o[3]); ow.z = cvt_pk_bf16(o[4], o[5]); ow.w = cvt_pk_bf16(o[6], o[7]);
            *(u32x4*)(XC + (size_t)(r0_ + i) * DR + ch) = ow;
        }
#undef CV_UNP
#undef CV_LOAD
    }
}

__device__ __forceinline__ int chunk_row(int bb, int c) { return c < 4 ? 8192 + bb * 256 + 64 * c : bb * 4096 + 64 * (c - 4); }

__device__ __forceinline__ void scan_pass1(const Ctx& C0) {
    const Ctx C = fresh(C0);
    const unsigned short* AB = (const unsigned short*)(C.ws + WS_AB);
    f32x2* PH = (f32x2*)(C.ws + WS_PH);
    const int gw = C.vcu * 8 + C.wave, NGW = C.G * 8;
    for (int item = gw; item < 2 * 68 * 20; item += NGW) {
        const int bb = item / (68 * 20), rem = item % (68 * 20), c = rem / 20, ch = (rem % 20) * 128 + 2 * C.lane;
        const int r0 = chunk_row(bb, c);
#pragma unroll
        for (int dir = 0; dir < 2; ++dir) {
            const unsigned short* A1 = AB + (size_t)(2 * dir) * ((size_t)QROWS * DR) + ch;
            const unsigned short* Bq = AB + (size_t)(2 * dir + 1) * ((size_t)QROWS * DR) + ch;
            float P0 = 1.f, P1 = 1.f, H0 = 0.f, H1 = 0.f;
#pragma unroll
            for (int t = 0; t < 64; ++t) { const int r = r0 + (dir ? 63 - t : t);
                const unsigned aw = *(const unsigned*)(A1 + (size_t)r * DR), bw = *(const unsigned*)(Bq + (size_t)r * DR);
                const float a0 = 1.0f - h_lo(aw), a1 = 1.0f - h_hi(aw);
                H0 = a0 * H0 + h_lo(bw); H1 = a1 * H1 + h_hi(bw); P0 *= a0; P1 *= a1; }
            const size_t o = ((size_t)(bb * 2 + dir) * 68 + c) * DR + ch;
            PH[o] = (f32x2){P0, H0}; PH[o + 1] = (f32x2){P1, H1};
        }
    }
}
__device__ __forceinline__ void scan_pass2(const Ctx& C0) {
    const Ctx C = fresh(C0);
    const f32x2* PH = (const f32x2*)(C.ws + WS_PH); float* CR = (float*)(C.ws + WS_CARRY);
    const int gt = C.vcu * 512 + C.tid;
    if (gt < 2 * 2 * DR) {
        const int bd = gt / DR, ch = gt % DR, dir = bd & 1;
        const f32x2* ph = PH + (size_t)bd * 68 * DR + ch; float* cr = CR + (size_t)bd * 68 * DR + ch;
        f32x2 v[68];
#pragma unroll
        for (int i = 0; i < 68; ++i) { const int c = dir ? (i < 4 ? 3 - i : 71 - i) : i; v[i] = ph[(size_t)c * DR]; }
        float st = 0.f;
#pragma unroll
        for (int i = 0; i < 68; ++i) { const int c = dir ? (i < 4 ? 3 - i : 71 - i) : i; cr[(size_t)c * DR] = st; st = v[i].x * st + v[i].y; }
    }
}
__device__ __forceinline__ void scan_pass3(const Ctx& C0, int q) {
    const Ctx C = fresh(C0);
    const unsigned short* AB = (const unsigned short*)(C.ws + WS_AB);
    const float* CR = (const float*)(C.ws + WS_CARRY);
    bf16_t* GG = (bf16_t*)(C.ws + WS_GG);
    const int gw = C.vcu * 8 + C.wave, NGW = C.G * 8;
    const size_t ARR = (size_t)QROWS * DR;
    for (int item = gw; item < 2 * 64 * 20; item += NGW) {
        const int bb = item / (64 * 20), rem = item % (64 * 20), c = 4 + rem / 20, ch = (rem % 20) * 128 + 2 * C.lane;
        const int r0 = chunk_row(bb, c);
        const int grow0 = (2 * q + bb) * SEQ + 64 * (c - 4);
        float hf0[64], hf1[64];
        { const unsigned short* A1 = AB + ch; const unsigned short* Bq = AB + ARR + ch;
          const size_t co = ((size_t)(bb * 2 + 0) * 68 + c) * DR + ch;
          float s0 = CR[co], s1 = CR[co + 1];
#pragma unroll
          for (int t = 0; t < 64; ++t) { const unsigned aw = *(const unsigned*)(A1 + (size_t)(r0 + t) * DR), bw = *(const unsigned*)(Bq + (size_t)(r0 + t) * DR);
              s0 = (1.0f - h_lo(aw)) * s0 + h_lo(bw); s1 = (1.0f - h_hi(aw)) * s1 + h_hi(bw); hf0[t] = s0; hf1[t] = s1; } }
        { const unsigned short* A1 = AB + 2 * ARR + ch; const unsigned short* Bq = AB + 3 * ARR + ch;
          const size_t co = ((size_t)(bb * 2 + 1) * 68 + c) * DR + ch;
          float s0 = CR[co], s1 = CR[co + 1];
          unsigned awb[2][8], bwb[2][8], ggb[2][8];
#define P3_LOAD(buf, blk) do { _Pragma("unroll") for (int k_ = 0; k_ < 8; ++k_) { const int t_ = (blk) * 8 + k_; awb[buf][k_] = *(const unsigned*)(A1 + (size_t)(r0 + t_) * DR); bwb[buf][k_] = *(const unsigned*)(Bq + (size_t)(r0 + t_) * DR); \
              ggb[buf][k_] = *(const unsigned*)(GG + (size_t)(grow0 + t_) * DR + ch); } } while (0)
          P3_LOAD(0, 7);
#pragma unroll
          for (int blk = 7; blk >= 0; --blk) {
              const int cb = (7 - blk) & 1;
              if (blk > 0) { if (cb == 0) P3_LOAD(1, blk - 1); else P3_LOAD(0, blk - 1); }
#pragma unroll
              for (int k = 7; k >= 0; --k) { const int t = blk * 8 + k; const unsigned aw = awb[cb][k], bw = bwb[cb][k], gw2 = ggb[cb][k];
                  s0 = (1.0f - h_lo(aw)) * s0 + h_lo(bw); s1 = (1.0f - h_hi(aw)) * s1 + h_hi(bw);
                  *(unsigned*)(GG + (size_t)(grow0 + t) * DR + ch) = cvt_pk_bf16((hf0[t] + s0) * bf_lo(gw2), (hf1[t] + s1) * bf_hi(gw2)); }
          }
#undef P3_LOAD
        }
    }
}


#define GRID_BAR() xcd_barrier(bar)
template <int LAYER, int F>
__device__ __forceinline__ void ffn_sub(const Ctx& C, const Params& P, const XcdBarrier& bar) {
    using namespace pg8;
    const float* MOD = (const float*)(C.ws + WS_MOD);
    float* X = (float*)(C.ws + WS_X);
    const int cid = (int)blockIdx.x;
    const float* modl = MOD + (size_t)LAYER * 9 * NMOD;
    constexpr int sub = F * 2, lf = LAYER * 2 + F;
    constexpr int Mf = (LAYER == 1 && F == 1) ? TL : T;
    { Gemm g{(const bf16_t*)(C.ws + WS_U), (const bf16_t*)(C.ws + WS_WGU) + (size_t)lf * 11264 * WP2, D, 64, D, (size_t)128, (size_t)32768}; StdOrder S; S.init(Mf, 2 * FF, D, D, D, C.G, cid);
      EpiSwiGLU E{(bf16_t*)(C.ws + WS_H)};
#ifndef NO_GU
      gemm_phase<EpiSwiGLU, StdOrder, true>(C.lds, g, S, E, C.wave);
#endif
    }
    if constexpr (lf == 0) {
        const int nun = (Mf / 256) * 44, rem = nun % C.G;
        if (rem == 0) prologue_mod(C, P, 1, cid, C.G); else if (cid >= rem) prologue_mod(C, P, 1, cid - rem, C.G - rem);
    }
    GRID_BAR();
    { Gemm g{(const bf16_t*)(C.ws + WS_H), (const bf16_t*)(C.ws + WS_WD) + (size_t)lf * D * WP5, 64, 64, FF, (size_t)32768, (size_t)32768};
      constexpr bool first = (LAYER == 0 && F == 0);
      constexpr int pls = first ? 0 : LAYER * 3 + sub - 1;
      EpiResid<!first> E{first ? PIN(0) : X, first ? PIN(2) : X + (size_t)TL * D, X, modl + (size_t)sub * 3 * D + 2 * D, 0.5f,
                 (const float*)(C.ws + WS_STATS), PIN(6) + (size_t)pls * D, PIN(7) + (size_t)pls * D, (float*)(C.ws + WS_PART)};
#ifndef NO_DOWN
      if constexpr (Mf == T) { SplitOrder S; S.init(64 * HKT, 64 * HKT, FF, C.G, cid); S.kqA = (size_t)(HKT / 4) * 32768; S.kqB = S.kqA; gemm_phase<EpiResid<!first>, SplitOrder, true>(C.lds, g, S, E, C.wave); }
      else { StdOrder S; S.init(Mf, D, 64 * HKT, 64 * HKT, FF, C.G, cid); gemm_phase<EpiResid<!first>, StdOrder, true>(C.lds, g, S, E, C.wave); }
#endif
    }
    if constexpr (lf < 3) {
        convert_in_tail(C, P, 0, wc::GU0 + (lf + 1) * 2 * wc::I_G, wc::GU0 + (lf + 2) * 2 * wc::I_G);
        convert_in_tail(C, P, 0, wc::WD0 + (lf + 1) * wc::I_D, wc::WD0 + (lf + 2) * wc::I_D);
    }
    GRID_BAR();
    if constexpr (LAYER == 1 && F == 1) {
        ln_phase(C, TL, PIN(6) + (size_t)(LAYER * 3 + sub) * D, PIN(7) + (size_t)(LAYER * 3 + sub) * D, nullptr, nullptr, POUT(), CtxComb{nullptr, nullptr, nullptr, nullptr, nullptr, 0.f, false});
    } else {
        const float* modn = (F == 0) ? modl + 1 * 3 * D : MOD + (size_t)(LAYER + 1) * 9 * NMOD;
        bf16_t* Un = (F == 0 && LAYER == 1) ? (bf16_t*)(C.ws + WS_ULRU) : (bf16_t*)(C.ws + WS_U);
        constexpr bool first = (LAYER == 0 && F == 0);
        constexpr int pls = first ? 0 : LAYER * 3 + sub - 1;
        ln_phase(C, T, PIN(6) + (size_t)(LAYER * 3 + sub) * D, PIN(7) + (size_t)(LAYER * 3 + sub) * D, modn, Un, nullptr,
                 CtxComb{(const float*)(C.ws + WS_PART), first ? PIN(2) : nullptr, PIN(6) + (size_t)pls * D, PIN(7) + (size_t)pls * D, modl + (size_t)sub * 3 * D + 2 * D + (size_t)8 * NMOD, 0.5f, true});
        GRID_BAR();
    }
}

__device__ __forceinline__ void attn_mixer(const Ctx& C, const Params& P, const XcdBarrier& bar) {
    using namespace pg8;
    const float* modl = (const float*)(C.ws + WS_MOD);
    float* X = (float*)(C.ws + WS_X);
    const int cid = (int)blockIdx.x;
    { Gemm g{(const bf16_t*)(C.ws + WS_U), (const bf16_t*)(C.ws + WS_WQK), D, WP2, D}; StdOrder S; S.init(T, 2 * D, D, WP2, D, C.G, cid);
      EpiQK E{(bf16_t*)(C.ws + WS_Q), (bf16_t*)(C.ws + WS_K), (const float*)(C.ws + WS_TAB)};
#ifndef NO_QK
      gemm_phase<EpiQK, StdOrder, true>(C.lds, g, S, E, C.wave);
#endif
    }
    { Gemm g{(const bf16_t*)(C.ws + WS_WV), (const bf16_t*)(C.ws + WS_U), WP2, D, D}; StdOrder S; S.init(D, T, WP2, D, D, C.G, C.G - 1 - cid);
      EpiBf16 E{(bf16_t*)(C.ws + WS_VT), T};
#ifndef NO_VT
      gemm_phase<EpiBf16, StdOrder, true>(C.lds, g, S, E, C.wave);
#endif
    }
    GRID_BAR();
#ifndef NO_ATT
    attn_phase(C, PIN(17));
#endif
    GRID_BAR();
    { Gemm g{(const bf16_t*)(C.ws + WS_O), (const bf16_t*)(C.ws + WS_WO), D, WP2, D}; SplitOrder S; S.init(D, WP2, D, C.G, cid);
      EpiResid<true> E{X, X + (size_t)TL * D, X, modl + 1 * 3 * D + 2 * D, 1.0f, (const float*)(C.ws + WS_STATS), PIN(6), PIN(7), (float*)(C.ws + WS_PART)};
#ifndef NO_WO
      gemm_phase<EpiResid<true>, SplitOrder, true>(C.lds, g, S, E, C.wave);
#endif
    }
    convert_in_tail(C, P, 0, wc::LRU0, wc::NITEMS);
    GRID_BAR();
    ln_phase(C, T, PIN(6) + (size_t)1 * D, PIN(7) + (size_t)1 * D, modl + 2 * 3 * D, (bf16_t*)(C.ws + WS_U), nullptr,
             CtxComb{(const float*)(C.ws + WS_PART), nullptr, PIN(6), PIN(7), modl + 1 * 3 * D + 2 * D + (size_t)8 * NMOD, 1.0f, true});
    GRID_BAR();
}

__device__ __forceinline__ void lru_mixer(const Ctx& C, const Params& P, const XcdBarrier& bar) {
    using namespace pg8;
    const float* modl = (const float*)(C.ws + WS_MOD) + (size_t)9 * NMOD;
    float* X = (float*)(C.ws + WS_X);
    const int cid = (int)blockIdx.x;
    { Gemm g{(const bf16_t*)(C.ws + WS_ULRU), (const bf16_t*)(C.ws + WS_WIN), D, WP2, D}; StdOrder S; S.init(T, 2 * DR, D, WP2, D, C.G, cid);
      EpiWin E{(bf16_t*)(C.ws + WS_GG), (bf16_t*)(C.ws + WS_XR)};
#ifndef NO_WIN
      gemm_phase<EpiWin, StdOrder, true>(C.lds, g, S, E, C.wave);
#endif
    }
    GRID_BAR();
#ifndef NO_CONV
    conv_phase(C, PIN(19), PIN(20));
#endif
    GRID_BAR();
#pragma unroll 1
    for (int q = 0; q < 4; ++q) {
        { Gemm g{(const bf16_t*)(C.ws + WS_XC), (const bf16_t*)(C.ws + WS_WAI), DR, 256, 256}; GateOrder S{C.G, cid, q};
          EpiGates E{(const bf16_t*)(C.ws + WS_XC), PIN(22), PIN(24), (const float*)(C.ws + WS_C8), (unsigned short*)(C.ws + WS_AB), q};
#ifndef NO_GATES
          gemm_phase<EpiGates, GateOrder, true>(C.lds, g, S, E, C.wave);
#endif
        }
        GRID_BAR();
#ifndef NO_SCAN
        scan_pass1(C);
#endif
        GRID_BAR();
#ifndef NO_SCAN
        scan_pass2(C);
#endif
        GRID_BAR();
#ifndef NO_SCAN3
        scan_pass3(C, q);
#endif
        GRID_BAR();
    }
    { Gemm g{(const bf16_t*)(C.ws + WS_GG), (const bf16_t*)(C.ws + WS_WOUT), DR, WPR, DR}; StdOrder S; S.init(TL, D, DR, WPR, DR, C.G, cid);
      EpiResid<true> E{X, X + (size_t)TL * D, X, modl + 1 * 3 * D + 2 * D, 1.0f, (const float*)(C.ws + WS_STATS), PIN(6) + (size_t)3 * D, PIN(7) + (size_t)3 * D, nullptr};
#ifndef NO_WOUT
      gemm_phase<EpiResid<true>, StdOrder, true>(C.lds, g, S, E, C.wave);
#endif
    }
    GRID_BAR();
    ln_phase(C, TL, PIN(6) + (size_t)4 * D, PIN(7) + (size_t)4 * D, modl + 2 * 3 * D, (bf16_t*)(C.ws + WS_U), nullptr, CtxComb{nullptr, nullptr, nullptr, nullptr, nullptr, 0.f, false});
    GRID_BAR();
}

__global__ void __launch_bounds__(512, 2) fwd_kernel(Params P) {
    extern __shared__ __attribute__((aligned(16))) unsigned char lds_raw[];
    Ctx C;
    C.lds = (LAS unsigned char*)lds_raw; C.ws = P.ws;
    C.tid = threadIdx.x; C.lane = C.tid & 63; C.wave = __builtin_amdgcn_readfirstlane(C.tid >> 6);
    C.G = gridDim.x; { const int bx = blockIdx.x; C.vcu = (C.G % 8 == 0) ? (bx % 8) * (C.G / 8) + bx / 8 : bx; }
    volatile LAS unsigned* MISC = (volatile LAS unsigned*)(C.lds + MISC_OFF);
    if (C.tid < 32) MISC[C.tid] = 0u;
    __syncthreads();
    XcdBarrier bar = xcd_barrier_post((unsigned*)(C.ws + WS_CTL) + CW_BAR, MISC + 8);

#ifndef NO_PRO
    prologue_mod(C, P, 0, C.vcu, C.G);
    prologue_small(C, P);
    { const int w = C.vcu * 8 + C.wave, n = C.G * 8;
      convert_weights(C, P, wc::GU0, wc::GU0 + 2 * wc::I_G, w, n); convert_weights(C, P, wc::WD0, wc::WD0 + wc::I_D, w, n); convert_weights(C, P, wc::ATT0, wc::LRU0, w, n); }
#endif
    GRID_BAR();
    prep_phase(C, P);
    GRID_BAR();


    ffn_sub<0, 0>(C, P, bar);
    attn_mixer(C, P, bar);
    ffn_sub<0, 1>(C, P, bar);
    ffn_sub<1, 0>(C, P, bar);
    lru_mixer(C, P, bar);
    ffn_sub<1, 1>(C, P, bar);
}

extern "C" void kernel_launch(void* const* d_in, const int* in_sizes, int n_in, void* d_out, int out_size, void* d_ws, size_t ws_size, hipStream_t stream) {
    static int grid = 0;
    if (grid == 0) {
        if (n_in != 27 || ws_size < WS_END) { fprintf(stderr, "kernel_launch: unexpected n_in %d / ws_size %zu (need %zu)\n", n_in, ws_size, (size_t)WS_END); grid = -1; return; }
        int dev = 0, cus = 0, per_cu = 0;
        if (hipGetDevice(&dev) != hipSuccess || hipDeviceGetAttribute(&cus, hipDeviceAttributeMultiprocessorCount, dev) != hipSuccess) { grid = -1; return; }
        if (hipFuncSetAttribute((const void*)fwd_kernel, hipFuncAttributeMaxDynamicSharedMemorySize, LDS_BYTES) != hipSuccess) { fprintf(stderr, "kernel_launch: hipFuncSetAttribute failed\n"); grid = -1; return; }
        if (hipOccupancyMaxActiveBlocksPerMultiprocessor(&per_cu, (const void*)fwd_kernel, 512, LDS_BYTES) != hipSuccess || per_cu < 1) fprintf(stderr, "kernel_launch: occupancy query says %d\n", per_cu);
        (void)hipGetLastError();
        grid = cus;
    }
    if (grid < 0) return;
    (void)hipMemsetAsync((char*)d_ws + WS_CTL, 0, CTL_ZERO_BYTES, stream);
    Params p{};
    for (int i = 0; i < 27; ++i) p.in[i] = (const float*)d_in[i];
    p.out = (float*)d_out; p.ws = (unsigned char*)d_ws;
    hipLaunchKernelGGL(fwd_kernel, dim3(grid), dim3(512), LDS_BYTES, stream, p);
}
```

```cpp
#include <hip/hip_runtime.h>
#include <cstdio>
#include <cstdint>

#define LAS __attribute__((address_space(3)))
#define GAS __attribute__((address_space(1)))
typedef unsigned short bf16_t;
typedef short bf16x8 __attribute__((ext_vector_type(8)));
typedef float f32x4 __attribute__((ext_vector_type(4)));
typedef float f32x2 __attribute__((ext_vector_type(2)));
typedef float f32x16 __attribute__((ext_vector_type(16)));
typedef unsigned u32x4 __attribute__((ext_vector_type(4)));
typedef unsigned u32x2 __attribute__((ext_vector_type(2)));
typedef GAS unsigned gu32;

constexpr int D = 2048, NB = 8, SEQ = 4096, CTXL = 256;
constexpr int TL = NB * SEQ;
constexpr int TC = NB * CTXL;
constexpr int T = TL + TC;
constexpr int HKT = 5632 / 64;
constexpr int WP2 = 2048 + 64, WP5 = 5632 + 128, WPR = 2560 + 64;
constexpr int FF = 5632, DR = 2560, NMOD = 9 * D;
constexpr float ALPHA = 1.4142135623730951f;
constexpr float LN_EPS = 1e-6f;
constexpr float LOG2E = 1.4426950408889634f;
constexpr float QSCALE = 0.125f * LOG2E;
constexpr int QROWS = 34 * 256;

constexpr size_t MiB = 1u << 20;
constexpr size_t WS_CTL = 0, CTL_ZERO_BYTES = 1 * MiB;
constexpr size_t WS_MOD = 1 * MiB;
constexpr size_t WS_TAB = 3 * MiB;
constexpr size_t WS_LAM = 3 * MiB + 16384;
constexpr size_t WS_C8 = 3 * MiB + 32768;
constexpr size_t WS_STATS = 3 * MiB + 131072;
constexpr size_t WS_WGU = 4 * MiB;
constexpr size_t SZ_WGU = (size_t)11264 * WP2 * 2, SZ_WD = (size_t)2048 * WP5 * 2;
constexpr size_t WS_WD = 186 * MiB;
constexpr size_t WS_WQK = 276 * MiB, WS_WV = 293 * MiB, WS_WO = 302 * MiB;
constexpr size_t WS_WIN = 311 * MiB, WS_WAI = 332 * MiB, WS_WOUT = 337 * MiB;
static_assert(WS_WGU + 4 * SZ_WGU <= WS_WD && WS_WD + 4 * SZ_WD <= WS_WQK && WS_WQK + (size_t)4096 * WP2 * 2 <= WS_WV && WS_WV + (size_t)2048 * WP2 * 2 <= WS_WO && WS_WO + (size_t)2048 * WP2 * 2 <= WS_WIN
              && WS_WIN + (size_t)5120 * WP2 * 2 <= WS_WAI && WS_WAI + (size_t)10240 * 256 * 2 <= WS_WOUT && WS_WOUT + (size_t)2048 * WPR * 2 <= 348 * MiB, "weight map");
constexpr size_t WS_X = 348 * MiB;
constexpr size_t WS_U = 620 * MiB;
constexpr size_t WS_H = 756 * MiB;
constexpr size_t WS_Q = 756 * MiB, WS_K = 892 * MiB, WS_VT = 1028 * MiB, WS_O = 620 * MiB;
constexpr size_t WS_GG = 620 * MiB, WS_XR = 790 * MiB, WS_XC = 960 * MiB, WS_ULRU = 960 * MiB, WS_AB = 790 * MiB;
constexpr size_t AB_ARR = (size_t)QROWS * DR * 2;
constexpr size_t WS_PH = 1130 * MiB;
constexpr size_t WS_CARRY = 1138 * MiB;
constexpr size_t WS_PART = 1146 * MiB;
constexpr size_t WS_END = 1210 * MiB;
static_assert(WS_H + (size_t)T * FF * 2 <= WS_PART && WS_XC + (size_t)T * DR * 2 <= WS_PH, "activation map");
static_assert(WS_AB + 4 * AB_ARR <= WS_XC, "AB fits in XR's region");

constexpr int CW_BAR = 4096;
constexpr int LDS_BYTES = 147456;
constexpr int MISC_OFF = 131072 + 320;

typedef __bf16 bf16x2_t __attribute__((ext_vector_type(2)));
__device__ __forceinline__ unsigned cvt_pk_bf16(float lo, float hi) { f32x2 v = {lo, hi}; bf16x2_t b = __builtin_convertvector(v, bf16x2_t); return __builtin_bit_cast(unsigned, b); }
__device__ __forceinline__ unsigned f2bf(float f) { unsigned u = __builtin_bit_cast(unsigned, f); return (u + 0x7fffu + ((u >> 16) & 1u)) >> 16; }
__device__ __forceinline__ unsigned pk2(float lo, float hi) { return f2bf(lo) | (f2bf(hi) << 16); }
__device__ __forceinline__ float bf_lo(unsigned w) { return __uint_as_float(w << 16); }
__device__ __forceinline__ float bf_hi(unsigned w) { return __uint_as_float(w & 0xffff0000u); }
typedef _Float16 h2_t __attribute__((ext_vector_type(2)));
__device__ __forceinline__ unsigned pk_f16(float a, float b) { h2_t v = {(_Float16)a, (_Float16)b}; return __builtin_bit_cast(unsigned, v); }
__device__ __forceinline__ float h_lo(unsigned w) { h2_t v = __builtin_bit_cast(h2_t, w); return (float)v.x; }
__device__ __forceinline__ float h_hi(unsigned w) { h2_t v = __builtin_bit_cast(h2_t, w); return (float)v.y; }
__device__ __forceinline__ float fast_sigmoid(float x) { return __builtin_amdgcn_rcpf(1.0f + __builtin_amdgcn_exp2f(-LOG2E * x)); }
__device__ __forceinline__ int lane_id() { unsigned m = ~0u; asm volatile("" : "+s"(m)); int l = (int)__builtin_amdgcn_mbcnt_hi(m, __builtin_amdgcn_mbcnt_lo(m, 0u)); asm volatile("" : "+v"(l)); return l; }
__device__ __forceinline__ float wave_sum(float v) {
#pragma unroll
    for (int o = 1; o < 64; o <<= 1) v += __shfl_xor(v, o);
    return v;
}
__device__ __forceinline__ float swap32(float v) { return __shfl_xor(v, 32); }

#define XB_TMO      128
#define XB_XCNT(j)  (256  + 64 * (j))
#define XB_XSUB(j)  (1280 + 64 * (j))
#define XB_XGEN(j)  (2304 + 64 * (j))
#define XB_TOP      3328
#define XB_TOPGEN   3392
#define XCD_BAR_WORDS 3456
#define XB_SPIN_CAP (1u << 22)
__device__ __forceinline__ unsigned xb_ld(unsigned* p)              { return __hip_atomic_load(p, __ATOMIC_RELAXED, __HIP_MEMORY_SCOPE_AGENT); }
__device__ __forceinline__ unsigned xb_add(unsigned* p, unsigned v) { return __hip_atomic_fetch_add(p, v, __ATOMIC_RELAXED, __HIP_MEMORY_SCOPE_AGENT); }
__device__ __forceinline__ unsigned xb_xcc_id() { return (unsigned)__builtin_amdgcn_s_getreg((3 << 11) | 20) & 0xFu; }
#define XB_SPIN(cond, bar) do { unsigned _sp = 0; while (cond) { __builtin_amdgcn_s_sleep(1); \
    if ((++_sp & 255u) == 0u) { if (xb_ld(&(bar)[XB_TMO])) break; if (_sp > XB_SPIN_CAP) { atomicAdd(&(bar)[XB_TMO], 1u); break; } } } } while (0)
struct XcdBarrier { unsigned* bar; unsigned x; volatile LAS unsigned* st; int wave; };
__device__ __forceinline__ XcdBarrier xcd_barrier_post(unsigned* bar, volatile LAS unsigned* st) {
    XcdBarrier b; b.bar = bar; b.x = xb_xcc_id(); b.st = st; b.wave = __builtin_amdgcn_readfirstlane((int)(threadIdx.x >> 6));
    if (threadIdx.x == 0) (void)xb_add(&bar[XB_XCNT(b.x)], 1u);
    return b;
}
__device__ __forceinline__ void xcd_barrier_complete(unsigned* bar, unsigned x, unsigned& nloc, unsigned& nx) {
    const unsigned G = gridDim.x * gridDim.y * gridDim.z;
    unsigned sum, cnt, mine, sp = 0u;
    for (;;) {
        sum = 0u; cnt = 0u; mine = 0u;
#pragma unroll
        for (unsigned j = 0; j < 16; ++j) { const unsigned c = xb_ld(&bar[XB_XCNT(j)]); sum += c; cnt += (c > 0u) ? 1u : 0u; mine = (j == x) ? c : mine; }
        if (sum == G) break;
        __builtin_amdgcn_s_sleep(1);
        if ((++sp & 255u) == 0u) { if (xb_ld(&bar[XB_TMO])) break; if (sp > XB_SPIN_CAP) { atomicAdd(&bar[XB_TMO], 1u); break; } }
    }
    nloc = mine > 0u ? mine : 1u; nx = cnt > 0u ? cnt : 1u;
}
__device__ __forceinline__ void xcd_barrier(const XcdBarrier& b) {
    asm volatile("s_waitcnt vmcnt(0)" ::: "memory");
    __syncthreads();
    if (b.wave == 0 && lane_id() == 0) {
        unsigned* bar = b.bar;
        __builtin_amdgcn_s_waitcnt(0);
        unsigned nloc = b.st[0], nx = b.st[1];
        if (nloc == 0u) { xcd_barrier_complete(bar, b.x, nloc, nx); b.st[0] = nloc; b.st[1] = nx; }
        const unsigned old = xb_add(&bar[XB_XSUB(b.x)], 1u);
        const unsigned gen = old / nloc;
        if (old + 1u == (gen + 1u) * nloc) {
            __builtin_amdgcn_fence(__ATOMIC_RELEASE, "agent");
            asm volatile("s_waitcnt vmcnt(0)" ::: "memory");
            const unsigned og = xb_add(&bar[XB_TOP], 1u);
            const unsigned tg = og / nx;
            if (og + 1u == (tg + 1u) * nx) xb_add(&bar[XB_TOPGEN], 1u);
            else XB_SPIN(xb_ld(&bar[XB_TOPGEN]) == tg, bar);
            __builtin_amdgcn_fence(__ATOMIC_ACQUIRE, "agent");
            xb_add(&bar[XB_XGEN(b.x)], 1u);
            asm volatile("s_waitcnt vmcnt(0)" ::: "memory");
        } else {
            XB_SPIN(xb_ld(&bar[XB_XGEN(b.x)]) == gen, bar);
            __builtin_amdgcn_fence(__ATOMIC_ACQUIRE, "agent");
            asm volatile("s_waitcnt vmcnt(0)" ::: "memory");
        }
    }
    __syncthreads();
}

namespace pg8 {
constexpr int BM = 256, BK = 64, HALF = 128, HTB = HALF * BK * 2, STAGE_BYTES = 8 * HTB, NXCD = 8, WGM = 4;
__host__ __device__ __forceinline__ int lds_byte(int r, int c) { const int st = (r >> 4) * 2 + (c >> 5), rr = r & 15, cc = c & 31, ob = rr * 64 + cc * 2; return st * 1024 + (ob ^ (((ob >> 9) & 1) << 5)); }
__host__ __device__ __forceinline__ void stage_rc(int b, int& R, int& C) { const int st = b / 1024, sb = b % 1024, swz = sb ^ (((sb >> 9) & 1) << 5); R = (st >> 1) * 16 + swz / 64; C = (st & 1) * 32 + (swz % 64) / 2; }
__host__ __device__ __forceinline__ int perm32(int rho) { const int n = rho >> 4, i = rho & 15; return 8 * (i >> 2) + 4 * n + (i & 3); }

struct Unit { int pm, pn; size_t aoff, boff; int kt, part; };
struct Gemm { const bf16_t* A; const bf16_t* Bt; int lda, ldb, K; size_t kstepA = 128, kstepB = 128; };

__device__ __forceinline__ bool order_next(int nM, int nN, int G, int c, int i, int& pm, int& pn) {
    const int nwg = nM * nN; const long L = (long)i * G + c; if (L >= nwg) return false;
    int wgid = (int)L; { const int q = nwg / NXCD, r = nwg % NXCD, xcd = wgid % NXCD, off = wgid / NXCD; wgid = (xcd < r ? xcd * (q + 1) : r * (q + 1) + (xcd - r) * q) + off; }
    const int nig = WGM * nN, gid = wgid / nig, fm = gid * WGM, gsz = (nM - fm) < WGM ? (nM - fm) : WGM;
    pm = fm + ((wgid % nig) % gsz); pn = (wgid % nig) / gsz; return true;
}
struct StdOrder {
    int nM, nN, G, c, kt; size_t astep, bstep;
    __device__ __forceinline__ void init(int M, int N, int lda, int ldb, int K, int G_, int c_) { nM = M / BM; nN = N / BM; G = G_; c = c_; kt = K / BK; astep = (size_t)BM * lda * 2; bstep = (size_t)BM * ldb * 2; }
    __device__ __forceinline__ bool next(int i, Unit& u) const { if (!order_next(nM, nN, G, c, i, u.pm, u.pn)) return false; u.aoff = (size_t)u.pm * astep; u.boff = (size_t)u.pn * bstep; u.kt = kt; u.part = -1; return true; }
};
struct SplitOrder {
    int G, c, K; size_t astep, bstep, kqA, kqB;
    __device__ __forceinline__ void init(int lda, int ldb, int K_, int G_, int c_) { G = G_; c = c_; K = K_; astep = (size_t)BM * lda * 2; bstep = (size_t)BM * ldb * 2; kqA = (size_t)(K_ / 4) * 2; kqB = kqA; }
    __device__ __forceinline__ bool next(int i, Unit& u) const {
        if (order_next(128, 8, G, c, i, u.pm, u.pn)) { u.aoff = (size_t)u.pm * astep; u.boff = (size_t)u.pn * bstep; u.kt = K / BK; u.part = -1; return true; }
        const long s = (long)i * G + c - 1024; if (s < 0 || s >= 256) return false;
        const int cu = (int)s >> 2, ks = (int)s & 3, kq = K / 4;
        u.pm = 128 + (cu >> 3); u.pn = cu & 7; u.aoff = (size_t)u.pm * astep + (size_t)ks * kqA; u.boff = (size_t)u.pn * bstep + (size_t)ks * kqB; u.kt = kq / BK; u.part = ks; return true;
    }
};
struct GateOrder {
    int G, c, q;
    __device__ __forceinline__ bool next(int i, Unit& u) const {
        if (!order_next(34, 40, G, c, i, u.pm, u.pn)) return false;
        const int gp = u.pm < 32 ? 32 * q + u.pm : 128 + 2 * q + (u.pm - 32);
        const int blk = (u.pn % 20) >> 1;
        u.aoff = ((size_t)gp * BM * DR + (size_t)blk * 256) * 2; u.boff = (size_t)u.pn * BM * 256 * 2; u.kt = 4; u.part = -1; return true;
    }
};

template <class Epi, class Sched, bool ALIGN_EPI>
__device__ __forceinline__ void gemm_phase(LAS unsigned char* lds, const Gemm g, const Sched& S, const Epi& E, const int wid0) {
    int lane = lane_id(); int wid = wid0; asm volatile("" : "+v"(lane), "+s"(wid));
    const int tid = wid * 64 + lane, wr = wid >> 2, wc = wid & 3, fr = lane & 15, fq = lane >> 4;
    unsigned voffA[2], voffB[2];
#pragma unroll
    for (int i = 0; i < 2; ++i) { int R, C; stage_rc(tid * 16 + i * 8192, R, C); const int Rb = Epi::PERM ? ((R & ~31) + perm32(R & 31)) : R;
        voffA[i] = (unsigned)(R * g.lda + C) * 2u; voffB[i] = (unsigned)(Rb * g.ldb + C) * 2u; }
    const size_t kstep = g.kstepB, kstepA = g.kstepA;
    const size_t hstepA = (size_t)HALF * g.lda * 2, hstepB = (size_t)HALF * g.ldb * 2;
    const unsigned ldsw = (unsigned)wid * 1024u;
    const int aoff = lds_byte(wr * 64 + fr, fq * 8), boff = lds_byte(wc * 32 + fr, fq * 8);
#define PG8_SA(b, h) (((b) * 2 + (h)) * HTB)
#define PG8_SB(b, h) ((4 + (b) * 2 + (h)) * HTB)
#define PG8_STAGE(bufoff, gbase, voff) do { _Pragma("unroll") for (int _i = 0; _i < 2; ++_i) \
        __builtin_amdgcn_global_load_lds((const unsigned*)((const char*)(gbase) + (voff)[_i]), (LAS unsigned*)(lds + (bufoff) + ldsw + _i * 8192), 16, 0, 0); } while (0)
#define PG8_LDA(dst, b, h) do { _Pragma("unroll") for (int m = 0; m < 4; ++m) _Pragma("unroll") for (int k = 0; k < 2; ++k) dst[m][k] = *(const LAS bf16x8*)(lds + PG8_SA(b, h) + aoff + m * 2048 + k * 1024); } while (0)
#define PG8_LDB(dst, b, h) do { _Pragma("unroll") for (int n = 0; n < 2; ++n) _Pragma("unroll") for (int k = 0; k < 2; ++k) dst[n][k] = *(const LAS bf16x8*)(lds + PG8_SB(b, h) + boff + n * 2048 + k * 1024); } while (0)
#define PG8_MMA(ai, bj, At, Bt) do { __builtin_amdgcn_s_setprio(1); _Pragma("unroll") for (int m = 0; m < 4; ++m) _Pragma("unroll") for (int n = 0; n < 2; ++n) _Pragma("unroll") for (int k = 0; k < 2; ++k) \
        acc[ai][bj][m][n] = __builtin_amdgcn_mfma_f32_16x16x32_bf16(Bt[n][k], At[m][k], acc[ai][bj][m][n], 0, 0, 0); __builtin_amdgcn_s_setprio(0); } while (0)
#define PG8_WAIT_V(n) asm volatile("s_waitcnt vmcnt(" #n ")" ::: "memory")
#define PG8_WAIT_L(n) asm volatile("s_waitcnt lgkmcnt(" #n ")" ::: "memory")
#define PG8_BAR __builtin_amdgcn_s_barrier()
#define PG8_SCHED __builtin_amdgcn_sched_barrier(0)
    Unit cur, nxt; int ui = 0;
    if (!S.next(0, cur)) return;
    f32x4 acc[2][2][4][2];
#pragma unroll
    for (int a = 0; a < 2; ++a)
#pragma unroll
        for (int b = 0; b < 2; ++b)
#pragma unroll
            for (int m = 0; m < 4; ++m)
#pragma unroll
                for (int n = 0; n < 2; ++n) acc[a][b][m][n] = (f32x4){0.f, 0.f, 0.f, 0.f};
    bf16x8 At[4][2], B0[2][2], B1[2][2];
    const char* cA = (const char*)g.A + cur.aoff; const char* cB = (const char*)g.Bt + cur.boff;
    PG8_STAGE(PG8_SB(0, 0), cB, voffB); PG8_STAGE(PG8_SB(0, 1), cB + hstepB, voffB); PG8_STAGE(PG8_SA(0, 0), cA, voffA); PG8_STAGE(PG8_SA(0, 1), cA + hstepA, voffA);
    if (wr == 1) PG8_BAR;
    PG8_WAIT_V(2); PG8_BAR;
    PG8_STAGE(PG8_SB(1, 0), cB + kstep, voffB); PG8_STAGE(PG8_SA(1, 0), cA + kstepA, voffA); PG8_STAGE(PG8_SB(1, 1), cB + hstepB + kstep, voffB);
    PG8_WAIT_V(6); PG8_BAR;
    for (;;) {
        const bool has_next = S.next(ui + 1, nxt);
        const char* nA = has_next ? (const char*)g.A + nxt.aoff : cA; const char* nB = has_next ? (const char*)g.Bt + nxt.boff : cB;
        const int nt = cur.kt;
#pragma unroll 1
        for (int t = 0; t < nt; t += 2) {
            const bool last = (t == nt - 2);
            const char* a1 = cA + (size_t)(t + 1) * kstepA;
            const char* a2 = last ? nA : cA + (size_t)(t + 2) * kstepA; const char* b2 = last ? nB : cB + (size_t)(t + 2) * kstep;
            const char* a3 = a2 + kstepA; const char* b3 = b2 + kstep;
            PG8_LDB(B0, 0, 0); PG8_LDB(B1, 0, 1); PG8_SCHED; PG8_LDA(At, 0, 0); PG8_STAGE(PG8_SA(1, 1), a1 + hstepA, voffA);
            PG8_WAIT_V(8); PG8_WAIT_L(0); PG8_BAR; PG8_MMA(0, 0, At, B0); PG8_MMA(0, 1, At, B1); PG8_BAR; PG8_SCHED;
            PG8_LDA(At, 0, 1); PG8_STAGE(PG8_SB(0, 0), b2, voffB); PG8_STAGE(PG8_SB(0, 1), b2 + hstepB, voffB); PG8_STAGE(PG8_SA(0, 0), a2, voffA);
            PG8_WAIT_V(8); PG8_WAIT_L(0); PG8_BAR; PG8_MMA(1, 0, At, B0); PG8_MMA(1, 1, At, B1); PG8_BAR; PG8_SCHED;
            PG8_LDB(B0, 1, 0); PG8_LDB(B1, 1, 1); PG8_SCHED; PG8_LDA(At, 1, 0); PG8_STAGE(PG8_SA(0, 1), a2 + hstepA, voffA);
            PG8_WAIT_V(8); PG8_WAIT_L(0); PG8_BAR; PG8_MMA(0, 0, At, B0); PG8_MMA(0, 1, At, B1); PG8_BAR; PG8_SCHED;
            PG8_LDA(At, 1, 1); PG8_STAGE(PG8_SB(1, 0), b3, voffB); PG8_STAGE(PG8_SB(1, 1), b3 + hstepB, voffB); PG8_STAGE(PG8_SA(1, 0), a3, voffA);
            PG8_WAIT_V(8); PG8_WAIT_L(0); PG8_BAR; PG8_MMA(1, 0, At, B0); PG8_MMA(1, 1, At, B1); PG8_BAR; PG8_SCHED;
        }
        if constexpr (ALIGN_EPI) { if (wr == 0) PG8_BAR; }
        E(acc, cur, wr, wc, fr, fq);
        if (!has_next) break;
#pragma unroll
        for (int a = 0; a < 2; ++a)
#pragma unroll
            for (int b = 0; b < 2; ++b)
#pragma unroll
                for (int m = 0; m < 4; ++m)
#pragma unroll
                    for (int n = 0; n < 2; ++n) acc[a][b][m][n] = (f32x4){0.f, 0.f, 0.f, 0.f};
        cur = nxt; cA = nA; cB = nB; ++ui;
        if constexpr (ALIGN_EPI) { if (wr == 1) PG8_BAR; }
    }
    PG8_WAIT_V(0);
    if constexpr (!ALIGN_EPI) { if (wr == 0) PG8_BAR; }
    PG8_BAR;
#undef PG8_SA
#undef PG8_SB
#undef PG8_STAGE
#undef PG8_LDA
#undef PG8_LDB
#undef PG8_MMA
#undef PG8_WAIT_V
#undef PG8_WAIT_L
#undef PG8_BAR
#undef PG8_SCHED
}

typedef f32x4 Acc[2][2][4][2];

struct EpiSwiGLU {
    static constexpr bool PERM = true;
    bf16_t* H;
    __device__ __forceinline__ void operator()(const Acc& acc, const Unit& u, int wr, int wc, int fr, int fq) const {
        bf16_t* hp = H + (((size_t)u.pm * HKT + 2 * u.pn + (wc >> 1)) * 256 + wr * 64 + fr) * 64 + (wc & 1) * 32 + 8 * fq;
#pragma unroll
        for (int ai = 0; ai < 2; ++ai)
#pragma unroll
            for (int m = 0; m < 4; ++m) {
                const f32x4 g0 = acc[ai][0][m][0], g1 = acc[ai][0][m][1], u0 = acc[ai][1][m][0], u1 = acc[ai][1][m][1];
                float h[8];
#pragma unroll
                for (int j = 0; j < 4; ++j) { h[j] = g0[j] * fast_sigmoid(g0[j]) * u0[j]; h[4 + j] = g1[j] * fast_sigmoid(g1[j]) * u1[j]; }
                u32x4 w; w.x = cvt_pk_bf16(h[0], h[1]); w.y = cvt_pk_bf16(h[2], h[3]); w.z = cvt_pk_bf16(h[4], h[5]); w.w = cvt_pk_bf16(h[6], h[7]);
                *(u32x4*)(hp + (size_t)(ai * HALF + m * 16) * 64) = w;
            }
    }
};
template <bool LNIN> struct EpiResid {
    static constexpr bool PERM = false;
    const float* res_lat; const float* res_ctx; float* X; const float* gate_tab; float gscale;
    const float* stats; const float* lng; const float* lnb;
    float* part;
    __device__ __forceinline__ void operator()(const Acc& acc, const Unit& u, int wr, int wc, int fr, int fq) const {
        if (u.part >= 0) {
            float* pb = part + ((size_t)u.part * TC + (size_t)(u.pm - 128) * BM + wr * 64 + fr) * D + u.pn * BM + wc * 32 + 4 * fq;
#pragma unroll
            for (int ai = 0; ai < 2; ++ai)
#pragma unroll
                for (int m = 0; m < 4; ++m)
#pragma unroll
                    for (int bj = 0; bj < 2; ++bj)
#pragma unroll
                        for (int n = 0; n < 2; ++n) *(f32x4*)(pb + (size_t)(ai * HALF + m * 16) * D + bj * HALF + n * 16) = acc[ai][bj][m][n];
            return;
        }
        const int bidx = u.pm < 128 ? (u.pm >> 4) : 8;
        const int r0 = wr * 64 + fr, col0 = u.pn * BM + wc * 32 + 4 * fq;
        const float* gate = gate_tab + (size_t)bidx * NMOD + col0;
        const float* rbase = (u.pm < 128 ? res_lat + (size_t)u.pm * BM * D : res_ctx + (size_t)(u.pm - 128) * BM * D) + (size_t)r0 * D + col0;
        float* xbase = X + ((size_t)u.pm * BM + r0) * D + col0;
        const float* stp = stats + ((size_t)u.pm * BM + r0) * 2;
#pragma unroll
        for (int bj = 0; bj < 2; ++bj)
#pragma unroll
            for (int n = 0; n < 2; ++n) {
                const int co = bj * HALF + n * 16;
                const f32x4 gv = *(const f32x4*)(gate + co) * gscale;
                f32x4 ga = (f32x4){ALPHA, ALPHA, ALPHA, ALPHA}, ba = (f32x4){0.f, 0.f, 0.f, 0.f};
                if constexpr (LNIN) { ga = *(const f32x4*)(lng + col0 + co) * ALPHA; ba = *(const f32x4*)(lnb + col0 + co) * ALPHA; }
#pragma unroll
                for (int ai = 0; ai < 2; ++ai)
#pragma unroll
                    for (int m = 0; m < 4; ++m) { const int rr = ai * HALF + m * 16; const size_t ro = (size_t)rr * D + co;
                        f32x4 r = *(const f32x4*)(rbase + ro);
                        if constexpr (LNIN) { const f32x2 st = *(const f32x2*)(stp + rr * 2); r = (r - st.x) * st.y; }
                        *(f32x4*)(xbase + ro) = r * ga + ba + gv * acc[ai][bj][m][n]; }
                asm volatile("" ::: "memory"); }
    }
};
struct EpiQK {
    static constexpr bool PERM = true;
    bf16_t* Q; bf16_t* Kb; const float* tab;
    __device__ __forceinline__ void operator()(const Acc& acc, const Unit& u, int wr, int wc, int fr, int fq) const {
        const bool is_q = u.pn < 8, lat = u.pm < 128;
        bf16_t* dst = is_q ? Q : Kb;
        const int col0 = (u.pn & 7) * BM + wc * 32 + 8 * fq, row0 = u.pm * BM + wr * 64 + fr;
        const float sc = is_q ? QSCALE : 1.0f;
        const int ax = wc & 1;
#pragma unroll
        for (int ai = 0; ai < 2; ++ai) {
            const int prow = (4 * u.pm + 2 * ai + wr) & 63;
#pragma unroll
            for (int m = 0; m < 4; ++m) {
                const int pos = ax ? (16 * m + fr) : prow;
                f32x4 t0 = (f32x4){1.f, 0.f, 1.f, 0.f}, t1 = t0;
                if (lat) { const float* tp = tab + (size_t)(pos * 16 + 4 * fq) * 2; t0 = *(const f32x4*)tp; t1 = *(const f32x4*)(tp + 4); }
#pragma unroll
                for (int bj = 0; bj < 2; ++bj) {
                    const f32x4 v0 = acc[ai][bj][m][0], v1 = acc[ai][bj][m][1];
                    float o[8];
                    o[0] = v0[0] * t0[0] - v0[1] * t0[1]; o[1] = v0[0] * t0[1] + v0[1] * t0[0];
                    o[2] = v0[2] * t0[2] - v0[3] * t0[3]; o[3] = v0[2] * t0[3] + v0[3] * t0[2];
                    o[4] = v1[0] * t1[0] - v1[1] * t1[1]; o[5] = v1[0] * t1[1] + v1[1] * t1[0];
                    o[6] = v1[2] * t1[2] - v1[3] * t1[3]; o[7] = v1[2] * t1[3] + v1[3] * t1[2];
                    u32x4 w; w.x = cvt_pk_bf16(o[0] * sc, o[1] * sc); w.y = cvt_pk_bf16(o[2] * sc, o[3] * sc); w.z = cvt_pk_bf16(o[4] * sc, o[5] * sc); w.w = cvt_pk_bf16(o[6] * sc, o[7] * sc);
                    *(u32x4*)(dst + (size_t)(row0 + ai * HALF + m * 16) * D + col0 + bj * HALF) = w;
                }
            }
        }
    }
};
struct EpiBf16 {
    static constexpr bool PERM = true;
    bf16_t* O; int ldc;
    __device__ __forceinline__ void operator()(const Acc& acc, const Unit& u, int wr, int wc, int fr, int fq) const {
        const int row0 = u.pm * BM + wr * 64 + fr, col0 = u.pn * BM + wc * 32 + 8 * fq;
#pragma unroll
        for (int ai = 0; ai < 2; ++ai)
#pragma unroll
            for (int m = 0; m < 4; ++m) { bf16_t* rowp = O + (size_t)(row0 + ai * HALF + m * 16) * ldc + col0;
#pragma unroll
                for (int bj = 0; bj < 2; ++bj) { const f32x4 v0 = acc[ai][bj][m][0], v1 = acc[ai][bj][m][1];
                    u32x4 w; w.x = cvt_pk_bf16(v0[0], v0[1]); w.y = cvt_pk_bf16(v0[2], v0[3]); w.z = cvt_pk_bf16(v1[0], v1[1]); w.w = cvt_pk_bf16(v1[2], v1[3]);
                    *(u32x4*)(rowp + bj * HALF) = w; } }
    }
};
struct EpiWin {
    static constexpr bool PERM = true;
    bf16_t* GG; bf16_t* XR;
    __device__ __forceinline__ void operator()(const Acc& acc, const Unit& u, int wr, int wc, int fr, int fq) const {
        const bool isg = u.pn < 10;
        bf16_t* dst = isg ? GG : XR;
        const int row0 = u.pm * BM + wr * 64 + fr, col0 = (isg ? u.pn : u.pn - 10) * BM + wc * 32 + 8 * fq;
#pragma unroll
        for (int ai = 0; ai < 2; ++ai)
#pragma unroll
            for (int m = 0; m < 4; ++m) { bf16_t* rowp = dst + (size_t)(row0 + ai * HALF + m * 16) * DR + col0;
#pragma unroll
                for (int bj = 0; bj < 2; ++bj) { f32x4 v0 = acc[ai][bj][m][0], v1 = acc[ai][bj][m][1];
                    if (isg) {
#pragma unroll
                        for (int j = 0; j < 4; ++j) { const float x = v0[j], y = v1[j];
                            v0[j] = x * fast_sigmoid(1.5957691216057308f * (x + 0.044715f * x * x * x));
                            v1[j] = y * fast_sigmoid(1.5957691216057308f * (y + 0.044715f * y * y * y)); } }
                    u32x4 w; w.x = cvt_pk_bf16(v0[0], v0[1]); w.y = cvt_pk_bf16(v0[2], v0[3]); w.z = cvt_pk_bf16(v1[0], v1[1]); w.w = cvt_pk_bf16(v1[2], v1[3]);
                    *(u32x4*)(rowp + bj * HALF) = w; } }
    }
};
struct EpiGates {
    static constexpr bool PERM = true;
    const bf16_t* XC; const float* ba; const float* bi; const float* c8; unsigned short* AB; int q;
    __device__ __forceinline__ void operator()(const Acc& acc, const Unit& u, int wr, int wc, int fr, int fq) const {
        const int d = u.pn / 20, blk = (u.pn % 20) >> 1, half = u.pn & 1;
        const int ch0 = blk * 256 + half * 128 + wc * 32 + 8 * fq;
        const int gp = u.pm < 32 ? 32 * q + u.pm : 128 + 2 * q + (u.pm - 32);
        const int r0 = wr * 64 + fr;
        const bf16_t* xcp = XC + ((size_t)gp * BM + r0) * DR + ch0;
        unsigned short* A1 = AB + (size_t)(2 * d) * ((size_t)QROWS * DR) + ((size_t)u.pm * BM + r0) * DR + ch0;
        unsigned short* Bq = A1 + (size_t)QROWS * DR;
        u32x2 xall[2][2][4];
#pragma unroll
        for (int n = 0; n < 2; ++n)
#pragma unroll
            for (int ai = 0; ai < 2; ++ai)
#pragma unroll
                for (int m = 0; m < 4; ++m) xall[n][ai][m] = *(const u32x2*)(xcp + (size_t)(ai * HALF + m * 16) * DR + 4 * n);
#pragma unroll
        for (int n = 0; n < 2; ++n) {
            const f32x4 bav = *(const f32x4*)(ba + d * DR + ch0 + 4 * n), biv = *(const f32x4*)(bi + d * DR + ch0 + 4 * n), cv = *(const f32x4*)(c8 + d * DR + ch0 + 4 * n);
#pragma unroll
            for (int ai = 0; ai < 2; ++ai)
#pragma unroll
                for (int m = 0; m < 4; ++m) {
                    const size_t ro = (size_t)(ai * HALF + m * 16) * DR + 4 * n;
                    const u32x2 xw = xall[n][ai][m];
                    const float xc[4] = {bf_lo(xw.x), bf_hi(xw.x), bf_lo(xw.y), bf_hi(xw.y)};
                    f32x4 ga = acc[ai][0][m][n], gi = acc[ai][1][m][n];
                    asm volatile("" : "+v"(ga), "+v"(gi));
                    float am[4], bb[4];
#pragma unroll
                    for (int j = 0; j < 4; ++j) {
                        const float r = fast_sigmoid(ga[j] + bav[j]), ig = fast_sigmoid(gi[j] + biv[j]);
                        const float a = __builtin_amdgcn_exp2f(r * cv[j] * LOG2E);
                        const float a1 = 1.0f - a;
                        am[j] = a1; bb[j] = __builtin_sqrtf(a1 * (1.0f + a)) * ig * xc[j];
                    }
                    u32x2 wa, wb;
                    wa.x = pk_f16(am[0], am[1]); wa.y = pk_f16(am[2], am[3]); wb.x = pk_f16(bb[0], bb[1]); wb.y = pk_f16(bb[2], bb[3]);
                    *(u32x2*)(A1 + ro) = wa; *(u32x2*)(Bq + ro) = wb;
                    asm volatile("" ::: "memory");
                }
        }
    }
};
}

struct Params {
    const float* in[27];
    float* out;
    unsigned char* ws;
};

#define KAS __attribute__((address_space(4)))
__device__ __forceinline__ const float* ldparam(int k) { const KAS char* kp = (const KAS char*)__builtin_amdgcn_kernarg_segment_ptr(); asm volatile("" : "+s"(kp)); return *(const float* const KAS*)(kp + 8 * k); }
#define PIN(k) ldparam(k)
#define POUT() ((float*)ldparam(27))

struct Ctx {
    LAS unsigned char* lds;
    unsigned char* ws;
    int tid, lane, wave, vcu, G;
};

__device__ __forceinline__ Ctx fresh(const Ctx& C0) { Ctx R = C0; int l = lane_id(); int w = C0.wave; asm volatile("" : "+v"(l), "+s"(w)); R.lane = l; R.wave = w; R.tid = w * 64 + l; return R; }

template <bool QKPERM, int TKT = 0>
__device__ __forceinline__ void transpose_item(const float* W, int ldw, int k0, int n0, bf16_t* WT, int ldo, int orow0, LAS float* scr, int lane) {
    f32x4 ld[8];
#pragma unroll
    for (int i = 0; i < 8; ++i) ld[i] = *(const f32x4*)(W + (size_t)(k0 + 8 * i + (lane >> 3)) * ldw + n0 + 4 * (lane & 7));
#pragma unroll
    for (int i = 0; i < 8; ++i) { LAS float* d = scr + (8 * i + (lane >> 3)) * 33 + 4 * (lane & 7); d[0] = ld[i][0]; d[1] = ld[i][1]; d[2] = ld[i][2]; d[3] = ld[i][3]; }
    asm volatile("s_waitcnt lgkmcnt(0)" ::: "memory");
    const int c = lane & 7;
#pragma unroll
    for (int j = 0; j < 4; ++j) { const int n = (lane >> 3) + 8 * j; const LAS float* s = scr + (8 * c) * 33 + n;
        u32x4 o; o.x = pk2(s[0 * 33], s[1 * 33]); o.y = pk2(s[2 * 33], s[3 * 33]); o.z = pk2(s[4 * 33], s[5 * 33]); o.w = pk2(s[6 * 33], s[7 * 33]);
        const int np = QKPERM ? (2 * (n & 15) + (n >> 4)) : n;
        if constexpr (TKT > 0) { const int orow = orow0 + np; *(u32x4*)(WT + ((size_t)((orow >> 8) * TKT + (k0 >> 6)) * 256 + (orow & 255)) * 64 + 8 * c) = o; }
        else *(u32x4*)(WT + (size_t)(orow0 + np) * ldo + k0 + 8 * c) = o; }
    asm volatile("s_waitcnt lgkmcnt(0)" ::: "memory");
}

namespace wc {
constexpr int I_G = 32 * 176, I_D = 88 * 64, I_QK = 32 * 128, I_V = 32 * 64, I_O = 32 * 64, I_IN = 32 * 160, I_A = 20 * 32, I_OUT = 40 * 64;
constexpr int GU0 = 0, WD0 = 8 * I_G, ATT0 = WD0 + 4 * I_D, LRU0 = ATT0 + I_QK + I_V + I_O, NITEMS = LRU0 + I_IN + 2 * I_A + I_OUT;
}
__device__ __forceinline__ void convert_weights(const Ctx& C0, const Params& P, int lo, int hi, int widx, int wcount) {
    const Ctx C = fresh(C0);
    using namespace wc;
    LAS float* scr = (LAS float*)(C.lds + C.wave * 16384);
    bf16_t* Wgu = (bf16_t*)(C.ws + WS_WGU); bf16_t* Wd = (bf16_t*)(C.ws + WS_WD);
    for (int it = lo + widx; it < hi; it += wcount) {
        int r = it;
        if (r < 8 * I_G) {
            const int lf = r / (2 * I_G); r -= lf * 2 * I_G; const int which = r / I_G; r -= which * I_G;
            const int kb = r / 176, nb = r % 176, n0 = nb * 32;
            const float* W = (which ? PIN(9) : PIN(8)) + (size_t)lf * D * FF;
            transpose_item<false, 32>(W, FF, kb * 64, n0, Wgu + (size_t)lf * 11264 * WP2, WP2, 256 * (n0 >> 7) + (n0 & 127) + which * 128, scr, C.lane);
            continue; }
        r -= 8 * I_G;
        if (r < 4 * I_D) { const int lf = r / I_D; r -= lf * I_D; const int kb = r / 64, nb = r % 64;
            transpose_item<false, 88>(PIN(10) + (size_t)lf * FF * D, D, kb * 64, nb * 32, Wd + (size_t)lf * D * WP5, WP5, nb * 32, scr, C.lane); continue; }
        r -= 4 * I_D;
        if (r < I_QK) { const int kb = r / 128, nb = r % 128;
            transpose_item<true>(PIN(11), 3 * D, kb * 64, nb * 32, (bf16_t*)(C.ws + WS_WQK), WP2, nb * 32, scr, C.lane); continue; }
        r -= I_QK;
        if (r < I_V) { const int kb = r / 64, nb = r % 64;
            transpose_item<false>(PIN(11), 3 * D, kb * 64, 2 * D + nb * 32, (bf16_t*)(C.ws + WS_WV), WP2, nb * 32, scr, C.lane); continue; }
        r -= I_V;
        if (r < I_O) { const int kb = r / 64, nb = r % 64;
            transpose_item<false>(PIN(12), D, kb * 64, nb * 32, (bf16_t*)(C.ws + WS_WO), WP2, nb * 32, scr, C.lane); continue; }
        r -= I_O;
        if (r < I_IN) { const int kb = r / 160, nb = r % 160;
            transpose_item<false>(PIN(18), 2 * DR, kb * 64, nb * 32, (bf16_t*)(C.ws + WS_WIN), WP2, nb * 32, scr, C.lane); continue; }
        r -= I_IN;
        if (r < 2 * I_A) { const int which = r / I_A; r -= which * I_A; const int mat = r / 32; r -= mat * 32; const int kb = r / 8, nb = r % 8, n0 = nb * 32;
            const float* W = (which ? PIN(23) : PIN(21)) + (size_t)mat * 256 * 256;
            transpose_item<false>(W, 256, kb * 64, n0, (bf16_t*)(C.ws + WS_WAI), 256, (mat * 2 + (n0 >> 7)) * 256 + (n0 & 127) + which * 128, scr, C.lane); continue; }
        r -= 2 * I_A;
        { const int kb = r / 64, nb = r % 64;
            transpose_item<false>(PIN(26), D, kb * 64, nb * 32, (bf16_t*)(C.ws + WS_WOUT), WPR, nb * 32, scr, C.lane); }
    }
}

__device__ __forceinline__ void convert_in_tail(const Ctx& C, const Params& P, int nunits, int lo, int hi) {
    const int rem = nunits % C.G, cid = (int)blockIdx.x;
    if (rem == 0) convert_weights(C, P, lo, hi, cid * 8 + C.wave, C.G * 8);
    else if (cid >= rem) convert_weights(C, P, lo, hi, (cid - rem) * 8 + C.wave, (C.G - rem) * 8);
}

__device__ __forceinline__ void prologue_mod(const Ctx& C0, const Params& P, int layer, int wgi, int wgn) {
    const Ctx C = fresh(C0);
    LAS float* sc = (LAS float*)C.lds;
    LAS float* red = (LAS float*)(C.lds + 9 * 2048 * 4);
    for (int idx = C.tid; idx < 9 * D; idx += 512) { const int bidx = idx >> 11, k = idx & 2047; const float cv = bidx < 8 ? PIN(1)[bidx * D + k] : PIN(3)[k]; sc[idx] = cv / (1.0f + __expf(-cv)); }
    __syncthreads();
    float* MOD = (float*)(C.ws + WS_MOD);
    for (int item = wgi; item < 144; item += wgn) {
        const int n0 = item * 128;
        const float* W = PIN(4) + (size_t)layer * D * NMOD + n0 + 2 * C.lane;
        float a0[9], a1[9];
#pragma unroll
        for (int b = 0; b < 9; ++b) { a0[b] = 0.f; a1[b] = 0.f; }
        const int kbeg = C.wave * 256;
#pragma unroll 8
        for (int k = kbeg; k < kbeg + 256; ++k) {
            const f32x2 w = *(const f32x2*)(W + (size_t)k * NMOD);
#pragma unroll
            for (int b = 0; b < 9; ++b) { const float s = sc[b * 2048 + k]; a0[b] += s * w.x; a1[b] += s * w.y; }
        }
#pragma unroll
        for (int b = 0; b < 9; ++b) { red[(C.wave * 9 + b) * 128 + 2 * C.lane] = a0[b]; red[(C.wave * 9 + b) * 128 + 2 * C.lane + 1] = a1[b]; }
        __syncthreads();
        for (int idx = C.tid; idx < 9 * 128; idx += 512) { const int b = idx >> 7, col = idx & 127; float s = 0.f;
#pragma unroll
            for (int w = 0; w < 8; ++w) s += red[(w * 9 + b) * 128 + col];
            MOD[((size_t)layer * 9 + b) * NMOD + n0 + col] = s + PIN(5)[layer * NMOD + n0 + col]; }
        __syncthreads();
    }
}

__device__ __forceinline__ void prologue_small(const Ctx& C0, const Params& P) {
    const Ctx C = fresh(C0);
    if (C.vcu == 0) {
        float* tab = (float*)(C.ws + WS_TAB);
        for (int idx = C.tid; idx < 64 * 16; idx += 512) { const int pos = idx >> 4, j = idx & 15;
            const float inv = powf(10000.0f, -(float)(2 * j) / 32.0f); const float ang = (float)pos * inv;
            tab[2 * idx] = cosf(ang); tab[2 * idx + 1] = sinf(ang); }
        if (C.tid == 0) { float s1 = 0.f, s2 = 0.f; for (int i = 0; i < 64; ++i) { s1 += PIN(13)[i] * PIN(14)[i]; s2 += PIN(15)[i] * PIN(16)[i]; }
            *(float*)(C.ws + WS_LAM) = expf(s1) - expf(s2) + 0.2f; }
    }
    if (C.vcu == 1) {
        float* c8 = (float*)(C.ws + WS_C8);
        for (int idx = C.tid; idx < 2 * DR; idx += 512) { const float ap = PIN(25)[idx]; c8[idx] = -8.0f * log1pf(expf(-ap)); }
    }
}

__device__ __forceinline__ void prep_phase(const Ctx& C0, const Params& P) {
    const Ctx C = fresh(C0);
    const float* MOD = (const float*)(C.ws + WS_MOD);
    bf16_t* U = (bf16_t*)(C.ws + WS_U);
    const int gw = C.vcu * 8 + C.wave, NGW = C.G * 8;
    const float* xin = PIN(0); const float* cin = PIN(2);
    f32x4 xv[8], nx[8];
    if (gw < T) { const float* xr = (gw < TL ? xin + (size_t)gw * D : cin + (size_t)(gw - TL) * D) + 4 * C.lane;
#pragma unroll
        for (int j = 0; j < 8; ++j) xv[j] = *(const f32x4*)(xr + 256 * j); }
    for (int row = gw; row < T; row += NGW) {
        const int bidx = row < TL ? (row >> 12) : 8;
        const int nrow = row + NGW;
        if (nrow < T) { const float* xr = (nrow < TL ? xin + (size_t)nrow * D : cin + (size_t)(nrow - TL) * D) + 4 * C.lane;
#pragma unroll
            for (int j = 0; j < 8; ++j) nx[j] = *(const f32x4*)(xr + 256 * j); }
        const float* sh = MOD + (size_t)bidx * NMOD + 4 * C.lane; const float* scl = sh + D;
#pragma unroll
        for (int j = 0; j < 8; ++j) { const f32x4 v = xv[j], s4 = *(const f32x4*)(sh + 256 * j), c4 = *(const f32x4*)(scl + 256 * j);
            const f32x4 o = v * (c4 + 1.0f) + s4; u32x2 w; w.x = cvt_pk_bf16(o[0], o[1]); w.y = cvt_pk_bf16(o[2], o[3]);
            *(u32x2*)(U + (size_t)row * D + 256 * j + 4 * C.lane) = w; }
#pragma unroll
        for (int j = 0; j < 8; ++j) xv[j] = nx[j];
    }
}

struct CtxComb { const float* part; const float* res_raw; const float* pg; const float* pb; const float* gate; float gscale; bool on; };
__device__ __forceinline__ void ln_phase(const Ctx& C0, int M, const float* lng, const float* lnb, const float* modn  , bf16_t* U, float* out, const CtxComb cc) {
    const Ctx C = fresh(C0);
    float* X = (float*)(C.ws + WS_X);
    f32x2* ST = (f32x2*)(C.ws + WS_STATS);
    const int gw = C.vcu * 8 + C.wave, NGW = C.G * 8;
    f32x4 g[8], b[8];
#pragma unroll
    for (int j = 0; j < 8; ++j) { g[j] = *(const f32x4*)(lng + 256 * j + 4 * C.lane); b[j] = *(const f32x4*)(lnb + 256 * j + 4 * C.lane); }
    f32x4 v[8], nv[8]; bool have = false;
    if (gw < M && !(cc.on && gw >= TL)) { const float* xp = X + (size_t)gw * D + 4 * C.lane;
#pragma unroll
        for (int j = 0; j < 8; ++j) v[j] = *(const f32x4*)(xp + 256 * j);
        have = true; }
    for (int row = gw; row < M; row += NGW) {
        float* xr = X + (size_t)row * D + 4 * C.lane;
        float s = 0.f;
        const int nrow = row + NGW; const bool nhave = nrow < M && !(cc.on && nrow >= TL);
        if (nhave) { const float* xp = X + (size_t)nrow * D + 4 * C.lane;
#pragma unroll
            for (int j = 0; j < 8; ++j) nv[j] = *(const f32x4*)(xp + 256 * j); }
        if (have) {   } else if (cc.on && row >= TL) {
            const size_t co = (size_t)(row - TL) * D + 4 * C.lane;
            f32x2 ost = (f32x2){0.f, 1.f}; if (!cc.res_raw) ost = ST[row];
#pragma unroll
            for (int j = 0; j < 8; ++j) { const float* pp = cc.part + co + 256 * j;
                const f32x4 sum = (*(const f32x4*)pp + *(const f32x4*)(pp + (size_t)TC * D)) + (*(const f32x4*)(pp + (size_t)2 * TC * D) + *(const f32x4*)(pp + (size_t)3 * TC * D));
                f32x4 r;
                if (cc.res_raw) r = *(const f32x4*)(cc.res_raw + co + 256 * j);
                else r = (*(const f32x4*)(xr + 256 * j) - ost.x) * ost.y * *(const f32x4*)(cc.pg + 256 * j + 4 * C.lane) + *(const f32x4*)(cc.pb + 256 * j + 4 * C.lane);
                v[j] = r * ALPHA + *(const f32x4*)(cc.gate + 256 * j + 4 * C.lane) * cc.gscale * sum;
                *(f32x4*)(xr + 256 * j) = v[j]; }
        } else {
#pragma unroll
            for (int j = 0; j < 8; ++j) v[j] = *(const f32x4*)(xr + 256 * j);
        }
#pragma unroll
        for (int j = 0; j < 8; ++j) s += (v[j][0] + v[j][1]) + (v[j][2] + v[j][3]);
        const float mean = wave_sum(s) * (1.0f / D); float s2 = 0.f;
#pragma unroll
        for (int j = 0; j < 8; ++j) { v[j] = v[j] - mean; s2 += (v[j][0] * v[j][0] + v[j][1] * v[j][1]) + (v[j][2] * v[j][2] + v[j][3] * v[j][3]); }
        const float rstd = 1.0f / sqrtf(wave_sum(s2) * (1.0f / D) + LN_EPS);
        if (C.lane == 0) ST[row] = (f32x2){mean, rstd};
#pragma unroll
        for (int j = 0; j < 8; ++j) v[j] = v[j] * rstd * g[j] + b[j];
        if (out) {
#pragma unroll
            for (int j = 0; j < 8; ++j) *(f32x4*)(out + (size_t)row * D + 256 * j + 4 * C.lane) = v[j];
        }
        if (modn) {
            const int bidx = row < TL ? (row >> 12) : 8;
            const float* sh = modn + (size_t)bidx * NMOD + 4 * C.lane; const float* scl = sh + D;
#pragma unroll
            for (int j = 0; j < 8; ++j) { const f32x4 s4 = *(const f32x4*)(sh + 256 * j), c4 = *(const f32x4*)(scl + 256 * j);
                const f32x4 o = v[j] * (c4 + 1.0f) + s4; u32x2 w; w.x = cvt_pk_bf16(o[0], o[1]); w.y = cvt_pk_bf16(o[2], o[3]);
                *(u32x2*)(U + (size_t)row * D + 256 * j + 4 * C.lane) = w; }
        }
#pragma unroll
        for (int j = 0; j < 8; ++j) v[j] = nv[j];
        have = nhave;
    }
}

namespace att {
constexpr int SLOT = 16384, LDS_K = 0, LDS_V = 4 * SLOT;
#define ATT_SBAR() __builtin_amdgcn_sched_barrier(0)
__device__ __forceinline__ float rowmax32(const f32x16& a, const f32x16& b) {
    float x = __builtin_fmaxf(__builtin_fmaxf(a[0], a[1]), b[0]), y = __builtin_fmaxf(__builtin_fmaxf(a[2], a[3]), b[1]);
    x = __builtin_fmaxf(__builtin_fmaxf(x, b[2]), b[3]);
#pragma unroll
    for (int r = 4; r < 16; r += 4) { x = __builtin_fmaxf(__builtin_fmaxf(x, a[r]), a[r + 1]); y = __builtin_fmaxf(__builtin_fmaxf(y, a[r + 2]), a[r + 3]); x = __builtin_fmaxf(__builtin_fmaxf(x, b[r]), b[r + 1]); y = __builtin_fmaxf(__builtin_fmaxf(y, b[r + 2]), b[r + 3]); }
    float m = __builtin_fmaxf(x, y);
    auto rr = __builtin_amdgcn_permlane32_swap(__float_as_uint(m), __float_as_uint(m), false, false);
    return __builtin_fmaxf(__uint_as_float(rr[0]), __uint_as_float(rr[1]));
}
__device__ __forceinline__ float halfsum(float x) { auto rr = __builtin_amdgcn_permlane32_swap(__float_as_uint(x), __float_as_uint(x), false, false); return __uint_as_float(rr[0]) + __uint_as_float(rr[1]); }
__device__ __forceinline__ void unit(const Ctx& C, const bf16_t* Q, const bf16_t* Kb, const bf16_t* VT, bf16_t* O, int qrow0, int h, int NT, int krow_ctx, int krow_lat, const float* lamp, const float* subg) {
    int lane = lane_id(); asm volatile("" : "+v"(lane));
    int wid = C.wave; asm volatile("" : "+s"(wid));
    const int l32 = lane & 31, hi = lane >> 5, qsub = wid >> 1, e = wid & 1;
    LAS unsigned char* lds = C.lds;
    unsigned koffl[2], voffl[2];
#pragma unroll
    for (int j = 0; j < 2; ++j) { const int p = 2 * wid + j;
        { const int r = 4 * p + (lane >> 4), c = (lane & 15) ^ (r & 15); koffl[j] = (unsigned)(r * D + h * 128 + c * 8) * 2u; }
        { const int v = 8 * p + (lane >> 3), c = (lane & 7) ^ ((v >> 1) & 7); voffl[j] = (unsigned)((h * 128 + v) * T + c * 8) * 2u; } }
#define ATT_KROW(t) ((t) < 4 ? krow_ctx + 64 * (t) : krow_lat + 64 * ((t) - 4))
#define ATT_DMA_K(t, slot) do { const char* b_ = (const char*)Kb + (size_t)ATT_KROW(t) * (D * 2); const int d_ = LDS_K + (slot) * SLOT + wid * 2048; \
        __builtin_amdgcn_global_load_lds((const unsigned*)(b_ + koffl[0]), (LAS unsigned*)(lds + d_), 16, 0, 0); \
        __builtin_amdgcn_global_load_lds((const unsigned*)(b_ + koffl[1]), (LAS unsigned*)(lds + d_ + 1024), 16, 0, 0); } while (0)
#define ATT_DMA_V(t, slotoff) do { const char* b_ = (const char*)VT + (size_t)ATT_KROW(t) * 2; const int d_ = LDS_V + (slotoff) + wid * 2048; \
        __builtin_amdgcn_global_load_lds((const unsigned*)(b_ + voffl[0]), (LAS unsigned*)(lds + d_), 16, 0, 0); \
        __builtin_amdgcn_global_load_lds((const unsigned*)(b_ + voffl[1]), (LAS unsigned*)(lds + d_ + 1024), 16, 0, 0); } while (0)
#define ATT_WAIT_BAR(N) do { asm volatile("" ::: "memory"); __builtin_amdgcn_s_waitcnt(0x0070 | (N)); asm volatile("s_barrier" ::: "memory"); } while (0)
    bf16x8 qf[4];
    { const bf16_t* qp = Q + (size_t)(qrow0 + 32 * qsub + l32) * D + h * 128 + e * 64 + 8 * hi;
#pragma unroll
      for (int ds = 0; ds < 4; ++ds) qf[ds] = *(const bf16x8*)(qp + 16 * ds); }
    ATT_DMA_K(0, 0); ATT_DMA_K(1, 1); ATT_DMA_K(2, 2); ATT_DMA_V(0, 0); ATT_DMA_K(3, 3); ATT_DMA_V(1, SLOT);
    const int pil = (l32 & ~12) | ((l32 & 4) << 1) | ((l32 & 8) >> 1);
    int kofs[4], vofs[4];
#pragma unroll
    for (int ds = 0; ds < 4; ++ds) kofs[ds] = LDS_K + pil * 256 + (((e * 8 + ds * 2 + hi) ^ (pil & 15)) << 4);
#pragma unroll
    for (int ks = 0; ks < 4; ++ks) vofs[ks] = LDS_V + l32 * 128 + (((2 * ks + hi) ^ ((l32 >> 1) & 7)) << 4);
#define ATT_KLD(dst, slot) do { _Pragma("unroll") for (int ds_ = 0; ds_ < 4; ++ds_) { dst[2 * ds_] = *(const LAS bf16x8*)(lds + (slot) * SLOT + kofs[ds_]); dst[2 * ds_ + 1] = *(const LAS bf16x8*)(lds + (slot) * SLOT + kofs[ds_] + 8192); } } while (0)
    f32x16 o[4];
#pragma unroll
    for (int vt = 0; vt < 4; ++vt)
#pragma unroll
        for (int r = 0; r < 16; ++r) o[vt][r] = 0.f;
    f32x16 negm;
    float mrow = 0.f, lsum = 0.f;
    bf16x8 kf[8];
    u32x4 pwA[4], pwB[4];
    f32x16 c0, c1;
    ATT_WAIT_BAR(8);
    ATT_KLD(kf, 0);
#pragma unroll
    for (int ds = 0; ds < 4; ++ds) { const f32x16 z16 = {0.f, 0.f, 0.f, 0.f, 0.f, 0.f, 0.f, 0.f, 0.f, 0.f, 0.f, 0.f, 0.f, 0.f, 0.f, 0.f};
        c0 = __builtin_amdgcn_mfma_f32_32x32x16_bf16(kf[2 * ds], qf[ds], ds == 0 ? z16 : c0, 0, 0, 0); c1 = __builtin_amdgcn_mfma_f32_32x32x16_bf16(kf[2 * ds + 1], qf[ds], ds == 0 ? z16 : c1, 0, 0, 0); }
    ATT_KLD(kf, 1);
    { const float rm = rowmax32(c0, c1); mrow = rm;
#pragma unroll
      for (int r = 0; r < 16; ++r) negm[r] = -mrow;
      asm volatile("" : "+v"(negm));
      float ps = 0.f;
#pragma unroll
      for (int r = 0; r < 16; ++r) { c0[r] = __builtin_amdgcn_exp2f(c0[r] - rm); c1[r] = __builtin_amdgcn_exp2f(c1[r] - rm); ps += c0[r] + c1[r]; }
      lsum = ps;
      pwA[0] = (u32x4){cvt_pk_bf16(c0[0], c0[1]), cvt_pk_bf16(c0[2], c0[3]), cvt_pk_bf16(c0[4], c0[5]), cvt_pk_bf16(c0[6], c0[7])};
      pwA[1] = (u32x4){cvt_pk_bf16(c0[8], c0[9]), cvt_pk_bf16(c0[10], c0[11]), cvt_pk_bf16(c0[12], c0[13]), cvt_pk_bf16(c0[14], c0[15])};
      pwA[2] = (u32x4){cvt_pk_bf16(c1[0], c1[1]), cvt_pk_bf16(c1[2], c1[3]), cvt_pk_bf16(c1[4], c1[5]), cvt_pk_bf16(c1[6], c1[7])};
      pwA[3] = (u32x4){cvt_pk_bf16(c1[8], c1[9]), cvt_pk_bf16(c1[10], c1[11]), cvt_pk_bf16(c1[12], c1[13]), cvt_pk_bf16(c1[14], c1[15])}; }
    int vs_prev = 0, vs_cur = SLOT, vs_next = 2 * SLOT;
#define ATT_ROT() do { const int t_ = vs_prev; vs_prev = vs_cur; vs_cur = vs_next; vs_next = t_; } while (0)
#define ATT_PEL(i) ((i) < 16 ? c0[(i) & 15] : c1[(i) & 15])
#define ATT_GAPB(g, VT_, VF, PWC, PWN, CV) do { o[VT_] = __builtin_amdgcn_mfma_f32_32x32x16_bf16(VF, __builtin_bit_cast(bf16x8, PWC[(g) >> 2]), o[VT_], 0, 0, 0); \
        { const float a_ = __builtin_amdgcn_exp2f(CV[(2 * (g)) & 15]), b_ = __builtin_amdgcn_exp2f(CV[(2 * (g) + 1) & 15]); \
          CV[(2 * (g)) & 15] = a_; CV[(2 * (g) + 1) & 15] = b_; lacc += a_; lacc += b_; PWN[(g) >> 2][(g) & 3] = cvt_pk_bf16(a_, b_); } ATT_SBAR(); } while (0)
#define ATT_VLD(dst, ks_) do { _Pragma("unroll") for (int vt_ = 0; vt_ < 4; ++vt_) dst[vt_] = *(const LAS bf16x8*)(vp_ + vofs[ks_] + vt_ * 4096); } while (0)
#define ATT_KLDH(dst, slot, h_) do { _Pragma("unroll") for (int ds_ = 2 * (h_); ds_ < 2 * (h_) + 2; ++ds_) { dst[2 * ds_] = *(const LAS bf16x8*)(lds + (slot) * SLOT + kofs[ds_]); dst[2 * ds_ + 1] = *(const LAS bf16x8*)(lds + (slot) * SLOT + kofs[ds_] + 8192); } } while (0)
#define ATT_STEP(PWC, PWN, T_, KREAD) do { \
        ATT_WAIT_BAR(4); \
        const LAS unsigned char* vp_ = lds + vs_prev; \
        bf16x8 vf0[4], vf1[4]; \
        ATT_VLD(vf0, 0); \
        ATT_SBAR(); \
        _Pragma("unroll") for (int ds_ = 0; ds_ < 4; ++ds_) { c0 = __builtin_amdgcn_mfma_f32_32x32x16_bf16(kf[2 * ds_], qf[ds_], ds_ == 0 ? negm : c0, 0, 0, 0); c1 = __builtin_amdgcn_mfma_f32_32x32x16_bf16(kf[2 * ds_ + 1], qf[ds_], ds_ == 0 ? negm : c1, 0, 0, 0); } \
        ATT_SBAR(); \
        { const int tk_ = (T_) + 3 < NT ? (T_) + 3 : NT - 1, tv_ = (T_) + 1 < NT ? (T_) + 1 : NT - 1; ATT_DMA_K(tk_, ((T_) + 3) & 3); ATT_DMA_V(tv_, vs_next); }     \
        ATT_SBAR(); \
        float fresc = 1.0f; bool resc = false; \
        { const float rm_ = rowmax32(c0, c1); \
          if (__builtin_expect(__any(rm_ > 8.0f), 0)) { const float dl_ = __builtin_fmaxf(rm_, 0.f); mrow += dl_; \
              _Pragma("unroll") for (int r_ = 0; r_ < 16; ++r_) { c0[r_] -= dl_; c1[r_] -= dl_; } \
              _Pragma("unroll") for (int r_ = 0; r_ < 16; ++r_) negm[r_] = -mrow; \
              asm volatile("" : "+v"(negm)); \
              fresc = __builtin_amdgcn_exp2f(-dl_); lsum *= fresc; resc = true; } } \
        ATT_SBAR(); \
        float lacc = 0.f; \
          \
        ATT_GAPB(0, 0, vf0[0], PWC, PWN, c0); ATT_VLD(vf1, 1); ATT_SBAR(); ATT_GAPB(1, 1, vf0[1], PWC, PWN, c0); ATT_GAPB(2, 2, vf0[2], PWC, PWN, c0); ATT_GAPB(3, 3, vf0[3], PWC, PWN, c0); \
        ATT_GAPB(4, 0, vf1[0], PWC, PWN, c0); ATT_VLD(vf0, 2); ATT_SBAR(); ATT_GAPB(5, 1, vf1[1], PWC, PWN, c0); ATT_GAPB(6, 2, vf1[2], PWC, PWN, c0); ATT_GAPB(7, 3, vf1[3], PWC, PWN, c0); \
        ATT_GAPB(8, 0, vf0[0], PWC, PWN, c1); ATT_VLD(vf1, 3); if (KREAD) { ATT_KLDH(kf, ((T_) + 1) & 3, 0); } ATT_SBAR(); ATT_GAPB(9, 1, vf0[1], PWC, PWN, c1); ATT_GAPB(10, 2, vf0[2], PWC, PWN, c1); ATT_GAPB(11, 3, vf0[3], PWC, PWN, c1); \
        ATT_GAPB(12, 0, vf1[0], PWC, PWN, c1); if (KREAD) { ATT_KLDH(kf, ((T_) + 1) & 3, 1); } ATT_SBAR(); ATT_GAPB(13, 1, vf1[1], PWC, PWN, c1); ATT_GAPB(14, 2, vf1[2], PWC, PWN, c1); ATT_GAPB(15, 3, vf1[3], PWC, PWN, c1); \
        lsum += lacc; \
        if (resc) { _Pragma("unroll") for (int vt_ = 0; vt_ < 4; ++vt_) _Pragma("unroll") for (int r_ = 0; r_ < 16; ++r_) o[vt_][r_] *= fresc; } \
        ATT_ROT(); \
    } while (0)
    int t = 1;
    for (; t + 2 < NT; t += 2) { ATT_STEP(pwA, pwB, t, true); ATT_STEP(pwB, pwA, t + 1, true); }
    ATT_STEP(pwA, pwB, t, false);
    ATT_WAIT_BAR(4);
    { const LAS unsigned char* vp_ = lds + vs_prev;
#pragma unroll
      for (int vt = 0; vt < 4; ++vt)
#pragma unroll
          for (int ks = 0; ks < 4; ++ks) { const bf16x8 vf = *(const LAS bf16x8*)(vp_ + vofs[ks] + vt * 4096);
              o[vt] = __builtin_amdgcn_mfma_f32_32x32x16_bf16(vf, __builtin_bit_cast(bf16x8, pwB[ks]), o[vt], 0, 0, 0); } }
    ATT_WAIT_BAR(0);
    const float ltot = halfsum(lsum);
    const float inv = 1.0f / ltot;
    LAS float* ex = (LAS float*)(lds + qsub * 16384);
    if (e == 1) {
        const float f = inv * *lamp;
#pragma unroll
        for (int vt = 0; vt < 4; ++vt)
#pragma unroll
            for (int r = 0; r < 16; ++r) { const int v = 32 * vt + (r & 3) + 8 * (r >> 2) + 4 * hi; ex[v * 32 + l32] = o[vt][r] * f; }
    }
    __syncthreads();
    if (e == 0) {
        float ss = 0.f;
#pragma unroll
        for (int vt = 0; vt < 4; ++vt)
#pragma unroll
            for (int r = 0; r < 16; ++r) { const int v = 32 * vt + (r & 3) + 8 * (r >> 2) + 4 * hi; const float d = o[vt][r] * inv - ex[v * 32 + l32]; o[vt][r] = d; ss += d * d; }
        ss = halfsum(ss);
        const float rs = 0.8f / sqrtf(ss * (1.0f / 128.0f) + LN_EPS);
        asm volatile("s_waitcnt lgkmcnt(0)" ::: "memory");
        LAS unsigned char* st = (LAS unsigned char*)ex;
        const float* sgp = subg; asm volatile("" : "+s"(sgp));
#pragma unroll
        for (int vt = 0; vt < 4; ++vt)
#pragma unroll
            for (int rg = 0; rg < 4; ++rg) { const int v = 32 * vt + 8 * rg + 4 * hi; const f32x4 gg = *(const f32x4*)(sgp + v);
                u32x2 w; w.x = cvt_pk_bf16(o[vt][4 * rg] * rs * gg[0], o[vt][4 * rg + 1] * rs * gg[1]); w.y = cvt_pk_bf16(o[vt][4 * rg + 2] * rs * gg[2], o[vt][4 * rg + 3] * rs * gg[3]);
                *(LAS u32x2*)(st + l32 * 272 + v * 2) = w; }
        asm volatile("s_waitcnt lgkmcnt(0)" ::: "memory");
#pragma unroll
        for (int i = 0; i < 8; ++i) { const int c = lane + 64 * i, row = c >> 4, cg = c & 15;
            const u32x4 v = *(const LAS u32x4*)(st + row * 272 + cg * 16);
            *(u32x4*)(O + (size_t)(qrow0 + 32 * qsub + row) * D + h * 128 + cg * 8) = v; }
    }
    asm volatile("s_waitcnt vmcnt(0)" ::: "memory");
    __syncthreads();
#undef ATT_KROW
#undef ATT_DMA_K
#undef ATT_DMA_V
#undef ATT_WAIT_BAR
#undef ATT_KLD
#undef ATT_ROT
#undef ATT_PEL
#undef ATT_GAPB
#undef ATT_VLD
#undef ATT_KLDH
#undef ATT_STEP
}
}

__device__ __forceinline__ void attn_phase(const Ctx& C, const float* subg) {
    const bf16_t* Q = (const bf16_t*)(C.ws + WS_Q); const bf16_t* Kb = (const bf16_t*)(C.ws + WS_K); const bf16_t* VT = (const bf16_t*)(C.ws + WS_VT);
    bf16_t* O = (bf16_t*)(C.ws + WS_O);
    const float* lamp = (const float*)(C.ws + WS_LAM);
    const int bx = blockIdx.x, G = C.G;
    for (int i = 0; i * G + bx < 4096; ++i) {
        const int uidx = i * G + bx;
        const int bh = (G == 256) ? (bx & 7) + 8 * i : (uidx >> 5), qb = (G == 256) ? (bx >> 3) : (uidx & 31);
        const int b = bh >> 4, h = bh & 15;
        att::unit(C, Q, Kb, VT, O, b * SEQ + qb * 128, h, 68, TL + b * CTXL, b * SEQ, lamp, subg);
    }
    for (int uidx = bx; uidx < 256; uidx += G) { const int bh = uidx >> 1, b = bh >> 4, h = bh & 15;
        att::unit(C, Q, Kb, VT, O, TL + b * CTXL + (uidx & 1) * 128, h, 4, TL + b * CTXL, 0, lamp, subg); }
}

__device__ __forceinline__ void conv_phase(const Ctx& C0, const float* cw, const float* cb) {
    const Ctx C = fresh(C0);
    const bf16_t* XR = (const bf16_t*)(C.ws + WS_XR); bf16_t* XC = (bf16_t*)(C.ws + WS_XC);
    const int gw = C.vcu * 8 + C.wave, NGW = C.G * 8;
    constexpr int NRB = T / 32;
    for (int item = gw; item < NRB * 5; item += NGW) {
        const int rb = item / 5, cg = item % 5, ch = cg * 512 + 8 * C.lane, r0_ = rb * 32;
        const int seglen = r0_ < TL ? SEQ : CTXL; const int sbase = r0_ < TL ? (r0_ & ~(SEQ - 1)) : TL + ((r0_ - TL) & ~(CTXL - 1));
        const int s0 = r0_ - sbase;
        float w[4][8], bias[8];
#pragma unroll
        for (int j = 0; j < 4; ++j) { const f32x4 a = *(const f32x4*)(cw + j * DR + ch), b = *(const f32x4*)(cw + j * DR + ch + 4);
#pragma unroll
            for (int k = 0; k < 4; ++k) { w[j][k] = a[k]; w[j][4 + k] = b[k]; } }
        { const f32x4 a = *(const f32x4*)(cb + ch), b = *(const f32x4*)(cb + ch + 4);
#pragma unroll
          for (int k = 0; k < 4; ++k) { bias[k] = a[k]; bias[4 + k] = b[k]; } }
        u32x4 rw[35];
#pragma unroll
        for (int i = 0; i < 35; ++i) { const int s_ = s0 + i - 2; rw[i] = (u32x4){0u, 0u, 0u, 0u}; if (s_ >= 0 && s_ < seglen) rw[i] = *(const u32x4*)(XR + (size_t)(sbase + s_) * DR + ch); }
#define CV_UNP(dst, x_) do { dst[0] = bf_lo(x_.x); dst[1] = bf_hi(x_.x); dst[2] = bf_lo(x_.y); dst[3] = bf_hi(x_.y); dst[4] = bf_lo(x_.z); dst[5] = bf_hi(x_.z); dst[6] = bf_lo(x_.w); dst[7] = bf_hi(x_.w); } while (0)
#pragma unroll
        for (int i = 0; i < 32; ++i) {
            float r0[8], r1[8], r2[8], r3[8], o[8];
            CV_UNP(r0, rw[i]); CV_UNP(r1, rw[i + 1]); CV_UNP(r2, rw[i + 2]); CV_UNP(r3, rw[i + 3]);
#pragma unroll
            for (int k = 0; k < 8; ++k) o[k] = bias[k] + w[0][k] * r0[k] + w[1][k] * r1[k] + w[2][k] * r2[k] + w[3][k] * r3[k];
            u32x4 ow; ow.x = cvt_pk_bf16(o[0], o[1]); ow.y = cvt_pk_bf16(o[2], o[3]); ow.z = cvt_pk_bf16(o[4], o[5]); ow.w = cvt_pk_bf16(o[6], o[7]);
            *(u32x4*)(XC + (size_t)(r0_ + i) * DR + ch) = ow;
        }
#undef CV_UNP
#undef CV_LOAD
    }
}

__device__ __forceinline__ int chunk_row(int bb, int c) { return c < 4 ? 8192 + bb * 256 + 64 * c : bb * 4096 + 64 * (c - 4); }

__device__ __forceinline__ void scan_pass1(const Ctx& C0) {
    const Ctx C = fresh(C0);
    const unsigned short* AB = (const unsigned short*)(C.ws + WS_AB);
    f32x2* PH = (f32x2*)(C.ws + WS_PH);
    const int gw = C.vcu * 8 + C.wave, NGW = C.G * 8;
    for (int item = gw; item < 2 * 68 * 20; item += NGW) {
        const int bb = item / (68 * 20), rem = item % (68 * 20), c = rem / 20, ch = (rem % 20) * 128 + 2 * C.lane;
        const int r0 = chunk_row(bb, c);
#pragma unroll
        for (int dir = 0; dir < 2; ++dir) {
            const unsigned short* A1 = AB + (size_t)(2 * dir) * ((size_t)QROWS * DR) + ch;
            const unsigned short* Bq = AB + (size_t)(2 * dir + 1) * ((size_t)QROWS * DR) + ch;
            float P0 = 1.f, P1 = 1.f, H0 = 0.f, H1 = 0.f;
#pragma unroll
            for (int t = 0; t < 64; ++t) { const int r = r0 + (dir ? 63 - t : t);
                const unsigned aw = *(const unsigned*)(A1 + (size_t)r * DR), bw = *(const unsigned*)(Bq + (size_t)r * DR);
                const float a0 = 1.0f - h_lo(aw), a1 = 1.0f - h_hi(aw);
                H0 = a0 * H0 + h_lo(bw); H1 = a1 * H1 + h_hi(bw); P0 *= a0; P1 *= a1; }
            const size_t o = ((size_t)(bb * 2 + dir) * 68 + c) * DR + ch;
            PH[o] = (f32x2){P0, H0}; PH[o + 1] = (f32x2){P1, H1};
        }
    }
}
__device__ __forceinline__ void scan_pass2(const Ctx& C0) {
    const Ctx C = fresh(C0);
    const f32x2* PH = (const f32x2*)(C.ws + WS_PH); float* CR = (float*)(C.ws + WS_CARRY);
    const int gt = C.vcu * 512 + C.tid;
    if (gt < 2 * 2 * DR) {
        const int bd = gt / DR, ch = gt % DR, dir = bd & 1;
        const f32x2* ph = PH + (size_t)bd * 68 * DR + ch; float* cr = CR + (size_t)bd * 68 * DR + ch;
        f32x2 v[68];
#pragma unroll
        for (int i = 0; i < 68; ++i) { const int c = dir ? (i < 4 ? 3 - i : 71 - i) : i; v[i] = ph[(size_t)c * DR]; }
        float st = 0.f;
#pragma unroll
        for (int i = 0; i < 68; ++i) { const int c = dir ? (i < 4 ? 3 - i : 71 - i) : i; cr[(size_t)c * DR] = st; st = v[i].x * st + v[i].y; }
    }
}
__device__ __forceinline__ void scan_pass3(const Ctx& C0, int q) {
    const Ctx C = fresh(C0);
    const unsigned short* AB = (const unsigned short*)(C.ws + WS_AB);
    const float* CR = (const float*)(C.ws + WS_CARRY);
    bf16_t* GG = (bf16_t*)(C.ws + WS_GG);
    const int gw = C.vcu * 8 + C.wave, NGW = C.G * 8;
    const size_t ARR = (size_t)QROWS * DR;
    for (int item = gw; item < 2 * 64 * 20; item += NGW) {
        const int bb = item / (64 * 20), rem = item % (64 * 20), c = 4 + rem / 20, ch = (rem % 20) * 128 + 2 * C.lane;
        const int r0 = chunk_row(bb, c);
        const int grow0 = (2 * q + bb) * SEQ + 64 * (c - 4);
        float hf0[64], hf1[64];
        { const unsigned short* A1 = AB + ch; const unsigned short* Bq = AB + ARR + ch;
          const size_t co = ((size_t)(bb * 2 + 0) * 68 + c) * DR + ch;
          float s0 = CR[co], s1 = CR[co + 1];
#pragma unroll
          for (int t = 0; t < 64; ++t) { const unsigned aw = *(const unsigned*)(A1 + (size_t)(r0 + t) * DR), bw = *(const unsigned*)(Bq + (size_t)(r0 + t) * DR);
              s0 = (1.0f - h_lo(aw)) * s0 + h_lo(bw); s1 = (1.0f - h_hi(aw)) * s1 + h_hi(bw); hf0[t] = s0; hf1[t] = s1; } }
        { const unsigned short* A1 = AB + 2 * ARR + ch; const unsigned short* Bq = AB + 3 * ARR + ch;
          const size_t co = ((size_t)(bb * 2 + 1) * 68 + c) * DR + ch;
          float s0 = CR[co], s1 = CR[co + 1];
          unsigned awb[2][8], bwb[2][8], ggb[2][8];
#define P3_LOAD(buf, blk) do { _Pragma("unroll") for (int k_ = 0; k_ < 8; ++k_) { const int t_ = (blk) * 8 + k_; awb[buf][k_] = *(const unsigned*)(A1 + (size_t)(r0 + t_) * DR); bwb[buf][k_] = *(const unsigned*)(Bq + (size_t)(r0 + t_) * DR); \
              ggb[buf][k_] = *(const unsigned*)(GG + (size_t)(grow0 + t_) * DR + ch); } } while (0)
          P3_LOAD(0, 7);
#pragma unroll
          for (int blk = 7; blk >= 0; --blk) {
              const int cb = (7 - blk) & 1;
              if (blk > 0) { if (cb == 0) P3_LOAD(1, blk - 1); else P3_LOAD(0, blk - 1); }
#pragma unroll
              for (int k = 7; k >= 0; --k) { const int t = blk * 8 + k; const unsigned aw = awb[cb][k], bw = bwb[cb][k], gw2 = ggb[cb][k];
                  s0 = (1.0f - h_lo(aw)) * s0 + h_lo(bw); s1 = (1.0f - h_hi(aw)) * s1 + h_hi(bw);
                  *(unsigned*)(GG + (size_t)(grow0 + t) * DR + ch) = cvt_pk_bf16((hf0[t] + s0) * bf_lo(gw2), (hf1[t] + s1) * bf_hi(gw2)); }
          }
#undef P3_LOAD
        }
    }
}


#define GRID_BAR() xcd_barrier(bar)
template <int LAYER, int F>
__device__ __forceinline__ void ffn_sub(const Ctx& C, const Params& P, const XcdBarrier& bar) {
    using namespace pg8;
    const float* MOD = (const float*)(C.ws + WS_MOD);
    float* X = (float*)(C.ws + WS_X);
    const int cid = (int)blockIdx.x;
    const float* modl = MOD + (size_t)LAYER * 9 * NMOD;
    constexpr int sub = F * 2, lf = LAYER * 2 + F;
    constexpr int Mf = (LAYER == 1 && F == 1) ? TL : T;
    { Gemm g{(const bf16_t*)(C.ws + WS_U), (const bf16_t*)(C.ws + WS_WGU) + (size_t)lf * 11264 * WP2, D, 64, D, (size_t)128, (size_t)32768}; StdOrder S; S.init(Mf, 2 * FF, D, D, D, C.G, cid);
      EpiSwiGLU E{(bf16_t*)(C.ws + WS_H)};
#ifndef NO_GU
      gemm_phase<EpiSwiGLU, StdOrder, true>(C.lds, g, S, E, C.wave);
#endif
    }
    if constexpr (lf == 0) {
        const int nun = (Mf / 256) * 44, rem = nun % C.G;
        if (rem == 0) prologue_mod(C, P, 1, cid, C.G); else if (cid >= rem) prologue_mod(C, P, 1, cid - rem, C.G - rem);
    }
    GRID_BAR();
    { Gemm g{(const bf16_t*)(C.ws + WS_H), (const bf16_t*)(C.ws + WS_WD) + (size_t)lf * D * WP5, 64, 64, FF, (size_t)32768, (size_t)32768};
      constexpr bool first = (LAYER == 0 && F == 0);
      constexpr int pls = first ? 0 : LAYER * 3 + sub - 1;
      EpiResid<!first> E{first ? PIN(0) : X, first ? PIN(2) : X + (size_t)TL * D, X, modl + (size_t)sub * 3 * D + 2 * D, 0.5f,
                 (const float*)(C.ws + WS_STATS), PIN(6) + (size_t)pls * D, PIN(7) + (size_t)pls * D, (float*)(C.ws + WS_PART)};
#ifndef NO_DOWN
      if constexpr (Mf == T) { SplitOrder S; S.init(64 * HKT, 64 * HKT, FF, C.G, cid); S.kqA = (size_t)(HKT / 4) * 32768; S.kqB = S.kqA; gemm_phase<EpiResid<!first>, SplitOrder, true>(C.lds, g, S, E, C.wave); }
      else { StdOrder S; S.init(Mf, D, 64 * HKT, 64 * HKT, FF, C.G, cid); gemm_phase<EpiResid<!first>, StdOrder, true>(C.lds, g, S, E, C.wave); }
#endif
    }
    if constexpr (lf < 3) {
        convert_in_tail(C, P, 0, wc::GU0 + (lf + 1) * 2 * wc::I_G, wc::GU0 + (lf + 2) * 2 * wc::I_G);
        convert_in_tail(C, P, 0, wc::WD0 + (lf + 1) * wc::I_D, wc::WD0 + (lf + 2) * wc::I_D);
    }
    GRID_BAR();
    if constexpr (LAYER == 1 && F == 1) {
        ln_phase(C, TL, PIN(6) + (size_t)(LAYER * 3 + sub) * D, PIN(7) + (size_t)(LAYER * 3 + sub) * D, nullptr, nullptr, POUT(), CtxComb{nullptr, nullptr, nullptr, nullptr, nullptr, 0.f, false});
    } else {
        const float* modn = (F == 0) ? modl + 1 * 3 * D : MOD + (size_t)(LAYER + 1) * 9 * NMOD;
        bf16_t* Un = (F == 0 && LAYER == 1) ? (bf16_t*)(C.ws + WS_ULRU) : (bf16_t*)(C.ws + WS_U);
        constexpr bool first = (LAYER == 0 && F == 0);
        constexpr int pls = first ? 0 : LAYER * 3 + sub - 1;
        ln_phase(C, T, PIN(6) + (size_t)(LAYER * 3 + sub) * D, PIN(7) + (size_t)(LAYER * 3 + sub) * D, modn, Un, nullptr,
                 CtxComb{(const float*)(C.ws + WS_PART), first ? PIN(2) : nullptr, PIN(6) + (size_t)pls * D, PIN(7) + (size_t)pls * D, modl + (size_t)sub * 3 * D + 2 * D + (size_t)8 * NMOD, 0.5f, true});
        GRID_BAR();
    }
}

__device__ __forceinline__ void attn_mixer(const Ctx& C, const Params& P, const XcdBarrier& bar) {
    using namespace pg8;
    const float* modl = (const float*)(C.ws + WS_MOD);
    float* X = (float*)(C.ws + WS_X);
    const int cid = (int)blockIdx.x;
    { Gemm g{(const bf16_t*)(C.ws + WS_U), (const bf16_t*)(C.ws + WS_WQK), D, WP2, D}; StdOrder S; S.init(T, 2 * D, D, WP2, D, C.G, cid);
      EpiQK E{(bf16_t*)(C.ws + WS_Q), (bf16_t*)(C.ws + WS_K), (const float*)(C.ws + WS_TAB)};
#ifndef NO_QK
      gemm_phase<EpiQK, StdOrder, true>(C.lds, g, S, E, C.wave);
#endif
    }
    { Gemm g{(const bf16_t*)(C.ws + WS_WV), (const bf16_t*)(C.ws + WS_U), WP2, D, D}; StdOrder S; S.init(D, T, WP2, D, D, C.G, C.G - 1 - cid);
      EpiBf16 E{(bf16_t*)(C.ws + WS_VT), T};
#ifndef NO_VT
      gemm_phase<EpiBf16, StdOrder, true>(C.lds, g, S, E, C.wave);
#endif
    }
    GRID_BAR();
#ifndef NO_ATT
    attn_phase(C, PIN(17));
#endif
    GRID_BAR();
    { Gemm g{(const bf16_t*)(C.ws + WS_O), (const bf16_t*)(C.ws + WS_WO), D, WP2, D}; SplitOrder S; S.init(D, WP2, D, C.G, cid);
      EpiResid<true> E{X, X + (size_t)TL * D, X, modl + 1 * 3 * D + 2 * D, 1.0f, (const float*)(C.ws + WS_STATS), PIN(6), PIN(7), (float*)(C.ws + WS_PART)};
#ifndef NO_WO
      gemm_phase<EpiResid<true>, SplitOrder, true>(C.lds, g, S, E, C.wave);
#endif
    }
    convert_in_tail(C, P, 0, wc::LRU0, wc::NITEMS);
    GRID_BAR();
    ln_phase(C, T, PIN(6) + (size_t)1 * D, PIN(7) + (size_t)1 * D, modl + 2 * 3 * D, (bf16_t*)(C.ws + WS_U), nullptr,
             CtxComb{(const float*)(C.ws + WS_PART), nullptr, PIN(6), PIN(7), modl + 1 * 3 * D + 2 * D + (size_t)8 * NMOD, 1.0f, true});
    GRID_BAR();
}

__device__ __forceinline__ void lru_mixer(const Ctx& C, const Params& P, const XcdBarrier& bar) {
    using namespace pg8;
    const float* modl = (const float*)(C.ws + WS_MOD) + (size_t)9 * NMOD;
    float* X = (float*)(C.ws + WS_X);
    const int cid = (int)blockIdx.x;
    { Gemm g{(const bf16_t*)(C.ws + WS_ULRU), (const bf16_t*)(C.ws + WS_WIN), D, WP2, D}; StdOrder S; S.init(T, 2 * DR, D, WP2, D, C.G, cid);
      EpiWin E{(bf16_t*)(C.ws + WS_GG), (bf16_t*)(C.ws + WS_XR)};
#ifndef NO_WIN
      gemm_phase<EpiWin, StdOrder, true>(C.lds, g, S, E, C.wave);
#endif
    }
    GRID_BAR();
#ifndef NO_CONV
    conv_phase(C, PIN(19), PIN(20));
#endif
    GRID_BAR();
#pragma unroll 1
    for (int q = 0; q < 4; ++q) {
        { Gemm g{(const bf16_t*)(C.ws + WS_XC), (const bf16_t*)(C.ws + WS_WAI), DR, 256, 256}; GateOrder S{C.G, cid, q};
          EpiGates E{(const bf16_t*)(C.ws + WS_XC), PIN(22), PIN(24), (const float*)(C.ws + WS_C8), (unsigned short*)(C.ws + WS_AB), q};
#ifndef NO_GATES
          gemm_phase<EpiGates, GateOrder, true>(C.lds, g, S, E, C.wave);
#endif
        }
        GRID_BAR();
#ifndef NO_SCAN
        scan_pass1(C);
#endif
        GRID_BAR();
#ifndef NO_SCAN
        scan_pass2(C);
#endif
        GRID_BAR();
#ifndef NO_SCAN3
        scan_pass3(C, q);
#endif
        GRID_BAR();
    }
    { Gemm g{(const bf16_t*)(C.ws + WS_GG), (const bf16_t*)(C.ws + WS_WOUT), DR, WPR, DR}; StdOrder S; S.init(TL, D, DR, WPR, DR, C.G, cid);
      EpiResid<true> E{X, X + (size_t)TL * D, X, modl + 1 * 3 * D + 2 * D, 1.0f, (const float*)(C.ws + WS_STATS), PIN(6) + (size_t)3 * D, PIN(7) + (size_t)3 * D, nullptr};
#ifndef NO_WOUT
      gemm_phase<EpiResid<true>, StdOrder, true>(C.lds, g, S, E, C.wave);
#endif
    }
    GRID_BAR();
    ln_phase(C, TL, PIN(6) + (size_t)4 * D, PIN(7) + (size_t)4 * D, modl + 2 * 3 * D, (bf16_t*)(C.ws + WS_U), nullptr, CtxComb{nullptr, nullptr, nullptr, nullptr, nullptr, 0.f, false});
    GRID_BAR();
}

__global__ void __launch_bounds__(512, 2) fwd_kernel(Params P) {
    extern __shared__ __attribute__((aligned(16))) unsigned char lds_raw[];
    Ctx C;
    C.lds = (LAS unsigned char*)lds_raw; C.ws = P.ws;
    C.tid = threadIdx.x; C.lane = C.tid & 63; C.wave = __builtin_amdgcn_readfirstlane(C.tid >> 6);
    C.G = gridDim.x; { const int bx = blockIdx.x; C.vcu = (C.G % 8 == 0) ? (bx % 8) * (C.G / 8) + bx / 8 : bx; }
    volatile LAS unsigned* MISC = (volatile LAS unsigned*)(C.lds + MISC_OFF);
    if (C.tid < 32) MISC[C.tid] = 0u;
    __syncthreads();
    XcdBarrier bar = xcd_barrier_post((unsigned*)(C.ws + WS_CTL) + CW_BAR, MISC + 8);

#ifndef NO_PRO
    prologue_mod(C, P, 0, C.vcu, C.G);
    prologue_small(C, P);
    { const int w = C.vcu * 8 + C.wave, n = C.G * 8;
      convert_weights(C, P, wc::GU0, wc::GU0 + 2 * wc::I_G, w, n); convert_weights(C, P, wc::WD0, wc::WD0 + wc::I_D, w, n); convert_weights(C, P, wc::ATT0, wc::LRU0, w, n); }
#endif
    GRID_BAR();
    prep_phase(C, P);
    GRID_BAR();


    ffn_sub<0, 0>(C, P, bar);
    attn_mixer(C, P, bar);
    ffn_sub<0, 1>(C, P, bar);
    ffn_sub<1, 0>(C, P, bar);
    lru_mixer(C, P, bar);
    ffn_sub<1, 1>(C, P, bar);
}

extern "C" void kernel_launch(void* const* d_in, const int* in_sizes, int n_in, void* d_out, int out_size, void* d_ws, size_t ws_size, hipStream_t stream) {
    static int grid = 0;
    if (grid == 0) {
        if (n_in != 27 || ws_size < WS_END) { fprintf(stderr, "kernel_launch: unexpected n_in %d / ws_size %zu (need %zu)\n", n_in, ws_size, (size_t)WS_END); grid = -1; return; }
        int dev = 0, cus = 0, per_cu = 0;
        if (hipGetDevice(&dev) != hipSuccess || hipDeviceGetAttribute(&cus, hipDeviceAttributeMultiprocessorCount, dev) != hipSuccess) { grid = -1; return; }
        if (hipFuncSetAttribute((const void*)fwd_kernel, hipFuncAttributeMaxDynamicSharedMemorySize, LDS_BYTES) != hipSuccess) { fprintf(stderr, "kernel_launch: hipFuncSetAttribute failed\n"); grid = -1; return; }
        if (hipOccupancyMaxActiveBlocksPerMultiprocessor(&per_cu, (const void*)fwd_kernel, 512, LDS_BYTES) != hipSuccess || per_cu < 1) fprintf(stderr, "kernel_launch: occupancy query says %d\n", per_cu);
        (void)hipGetLastError();
        grid = cus;
    }
    if (grid < 0) return;
    (void)hipMemsetAsync((char*)d_ws + WS_CTL, 0, CTL_ZERO_BYTES, stream);
    Params p{};
    for (int i = 0; i < 27; ++i) p.in[i] = (const float*)d_in[i];
    p.out = (float*)d_out; p.ws = (unsigned char*)d_ws;
    hipLaunchKernelGGL(fwd_kernel, dim3(grid), dim3(512), LDS_BYTES, stream, p);
}
```
